# Optimizing an MI355X kernel written in HIP

```python
import math
import jax, jax.numpy as jnp
from jax import lax
import numpy as np

D_MODEL = 1024
BATCH = 16
SEQ = 2048
DEPTH = 1

CHUNK = 64
DA_HEADS = D_MODEL // 128
DA_HEAD_DIM = 64
DA_V_DIM = 2 * DA_HEAD_DIM
DA_QK_WIDTH = DA_HEADS * 2 * DA_HEAD_DIM
DA_V_WIDTH = DA_HEADS * DA_V_DIM
ROT_DIM = DA_HEAD_DIM // 4
ROPE_THETA = 500000.0
Q_BLOCK = 128
GM_GROUPS = D_MODEL // 128
GM_GROUP_DIM = 128
GM_WIDTH = GM_GROUPS * GM_GROUP_DIM
GM_BLOCK = 128
N_BRANCHES = 2
D_FF = -(-8 * D_MODEL // (3 * 256)) * 256
EPS = 1e-6
SUBLN_EPS = 1e-5
IN_WIDTHS = (DA_QK_WIDTH, DA_QK_WIDTH, DA_V_WIDTH, GM_WIDTH, GM_WIDTH, N_BRANCHES * D_MODEL)
IN_SPLITS = tuple(int(s) for s in np.cumsum(IN_WIDTHS)[:-1])
D_IN = int(sum(IN_WIDTHS))

kernel_name = "hybrid_diffattn_gmlp_gated_block"


def rmsnorm(x, g, eps=EPS):
    xf = x.astype(jnp.float32)
    y = xf * lax.rsqrt(jnp.mean(xf * xf, axis=-1, keepdims=True) + eps)
    return (y * g.astype(jnp.float32)).astype(x.dtype)


def lambda_init_fn(layer):
    return 0.8 - 0.6 * math.exp(-0.3 * layer)


def rope_tables(positions, dtype):
    inv_freq = ROPE_THETA ** (-np.arange(0, ROT_DIM, 2, dtype=np.float32) / ROT_DIM)
    ang = positions.astype(jnp.float32)[..., None] * jnp.asarray(inv_freq)
    return jnp.cos(ang)[:, :, None, :].astype(dtype), jnp.sin(ang)[:, :, None, :].astype(dtype)


def partial_rope(x, cos, sin):
    half = ROT_DIM // 2
    x1, x2, rest = x[..., :half], x[..., half:ROT_DIM], x[..., ROT_DIM:]
    return jnp.concatenate([x1 * cos - x2 * sin, x2 * cos + x1 * sin, rest], axis=-1)


def diff_attention(q1, q2, k1, k2, v, lam):
    S = q1.shape[2]
    scale = DA_HEAD_DIM ** -0.5
    outs = []
    for qb in range(S // Q_BLOCK):
        lo, hi = qb * Q_BLOCK, (qb + 1) * Q_BLOCK
        qpos = np.arange(lo, hi)
        kpos = np.arange(hi)
        mask = (kpos[None, :] // CHUNK) <= (qpos[:, None] // CHUNK)

        def probs(q, k):
            s = jnp.einsum('bhqd,bhkd->bhqk', q[:, :, lo:hi], k[:, :, :hi]).astype(jnp.float32) * scale
            s = jnp.where(mask, s, -jnp.inf)
            return jax.nn.softmax(s, axis=-1)

        p = probs(q1, k1) - lam * probs(q2, k2)
        outs.append(jnp.einsum('bhqk,bhkd->bhqd', p.astype(v.dtype), v[:, :, :hi]))
    return jnp.concatenate(outs, axis=2)


def spatial_gating(u, vg, g_norm, w_s, b_s):
    B, S, _ = vg.shape
    vn = rmsnorm(vg, g_norm)
    vb = vn.reshape(B, S // GM_BLOCK, GM_BLOCK, GM_GROUPS, GM_GROUP_DIM)
    pos = np.arange(GM_BLOCK)
    mask = (pos[None, :] // CHUNK) <= (pos[:, None] // CHUNK)
    w = jnp.where(mask, w_s, 0.0)
    mixed = jnp.einsum('gij,bnjgc->bnigc', w, vb) + b_s.T[None, None, :, :, None]
    return u * mixed.reshape(B, S, GM_WIDTH)


def swiglu(h, w_in, w_out):
    a, b = jnp.split(h @ w_in, 2, axis=-1)
    return (jax.nn.silu(a) * b) @ w_out


def setup_inputs(seed: int = 0) -> dict:
    key = jax.random.key(seed)
    ks = jax.random.split(key, 16)
    f32 = jnp.float32
    x = jax.random.normal(ks[0], (BATCH, SEQ, D_MODEL), f32)
    offsets = jax.random.randint(ks[1], (BATCH,), 0, 4096, dtype=jnp.int32)
    positions = (jnp.arange(SEQ, dtype=jnp.int32)[None, :] + offsets[:, None]).astype(jnp.int32)
    norm_mix_g = 1.0 + 0.02 * jax.random.normal(ks[2], (DEPTH, D_MODEL), f32)
    w_in = jax.random.normal(ks[3], (DEPTH, D_MODEL, D_IN), f32) * D_MODEL ** -0.5
    gate_b = 0.02 * jax.random.normal(ks[4], (DEPTH, N_BRANCHES, D_MODEL), f32)
    lambdas = 0.1 * jax.random.normal(ks[5], (DEPTH, 4, DA_HEAD_DIM), f32)
    subln_g = 1.0 + 0.02 * jax.random.normal(ks[6], (DEPTH, DA_V_DIM), f32)
    gm_norm_g = 1.0 + 0.02 * jax.random.normal(ks[7], (DEPTH, GM_WIDTH), f32)
    gm_ws = jax.random.normal(ks[8], (DEPTH, GM_GROUPS, GM_BLOCK, GM_BLOCK), f32) * GM_BLOCK ** -0.5
    gm_bs = 1.0 + 0.02 * jax.random.normal(ks[9], (DEPTH, GM_GROUPS, GM_BLOCK), f32)
    w_out = jax.random.normal(ks[10], (DEPTH, D_MODEL, D_MODEL), f32) * D_MODEL ** -0.5
    norm_ffn_g = 1.0 + 0.02 * jax.random.normal(ks[11], (DEPTH, D_MODEL), f32)
    w_ffn_in = jax.random.normal(ks[12], (DEPTH, D_MODEL, 2 * D_FF), f32) * D_MODEL ** -0.5
    w_ffn_out = jax.random.normal(ks[13], (DEPTH, D_FF, D_MODEL), f32) * D_FF ** -0.5
    norm_final_g = 1.0 + 0.02 * jax.random.normal(ks[14], (D_MODEL,), f32)
    return {"x": x, "positions": positions, "norm_mix_g": norm_mix_g, "w_in": w_in,
            "gate_b": gate_b, "lambdas": lambdas, "subln_g": subln_g, "gm_norm_g": gm_norm_g,
            "gm_ws": gm_ws, "gm_bs": gm_bs, "w_out": w_out, "norm_ffn_g": norm_ffn_g,
            "w_ffn_in": w_ffn_in, "w_ffn_out": w_ffn_out, "norm_final_g": norm_final_g}


def reference(x, positions, norm_mix_g, w_in, gate_b, lambdas, subln_g, gm_norm_g,
              gm_ws, gm_bs, w_out, norm_ffn_g, w_ffn_in, w_ffn_out, norm_final_g):
    B, S, _ = x.shape
    cos, sin = rope_tables(positions, x.dtype)
    for l in range(DEPTH):
        lam_init = lambda_init_fn(l)
        h = rmsnorm(x, norm_mix_g[l])
        proj = h @ w_in[l]
        q, k, v, gu, gv, gates = jnp.split(proj, IN_SPLITS, axis=-1)

        q = q.reshape(B, S, DA_HEADS, 2, DA_HEAD_DIM)
        k = k.reshape(B, S, DA_HEADS, 2, DA_HEAD_DIM)
        to_bhsd = lambda t: partial_rope(t, cos, sin).transpose(0, 2, 1, 3)
        q1, q2 = to_bhsd(q[..., 0, :]), to_bhsd(q[..., 1, :])
        k1, k2 = to_bhsd(k[..., 0, :]), to_bhsd(k[..., 1, :])
        vh = v.reshape(B, S, DA_HEADS, DA_V_DIM).transpose(0, 2, 1, 3)
        lf = lambdas[l].astype(jnp.float32)
        lam = jnp.exp(jnp.sum(lf[0] * lf[1])) - jnp.exp(jnp.sum(lf[2] * lf[3])) + lam_init
        o = diff_attention(q1, q2, k1, k2, vh, lam).transpose(0, 2, 1, 3)
        o = rmsnorm(o, subln_g[l], SUBLN_EPS) * (1.0 - lam_init)
        attn_out = o.reshape(B, S, DA_V_WIDTH)

        gm_out = spatial_gating(jax.nn.gelu(gu, approximate=False), jax.nn.gelu(gv, approximate=False),
                                gm_norm_g[l], gm_ws[l], gm_bs[l])

        g = jax.nn.sigmoid(gates.reshape(B, S, N_BRANCHES, D_MODEL) + gate_b[l])
        merged = g[:, :, 0, :] * attn_out + g[:, :, 1, :] * gm_out
        x = x + merged @ w_out[l]

        x = x + swiglu(rmsnorm(x, norm_ffn_g[l]), w_ffn_in[l], w_ffn_out[l])
    return rmsnorm(x, norm_final_g)
```

```cpp
#include <hip/hip_runtime.h>
#include <cstdio>
#include <cstdint>
#ifndef EPI_PLAIN
#define EPI_PLAIN 0
#endif
namespace pg8 {
#define PG8_LAS __attribute__((address_space(3)))
typedef unsigned short bf16_t;
typedef short bf16x8 __attribute__((ext_vector_type(8)));
typedef float f32x4 __attribute__((ext_vector_type(4)));
typedef unsigned u32x4 __attribute__((ext_vector_type(4)));
constexpr int BM = 256, BK = 64, HALF = 128, HTB = HALF * BK * 2  , STAGE_BYTES = 8 * HTB, NXCD = 8, WGM = 8;

__host__ __device__ __forceinline__ int lds_byte(int r, int c) { const int st = (r >> 4) * 2 + (c >> 5), rr = r & 15, cc = c & 31, ob = rr * 64 + cc * 2; return st * 1024 + (ob ^ (((ob >> 9) & 1) << 5)); }
__host__ __device__ __forceinline__ void stage_rc(int b, int& R, int& C) { const int st = b / 1024, sb = b % 1024, swz = sb ^ (((sb >> 9) & 1) << 5); R = (st >> 1) * 16 + swz / 64; C = (st & 1) * 32 + (swz % 64) / 2; }
__host__ __device__ __forceinline__ int perm32(int rho) { const int n = rho >> 4, i = rho & 15; return 8 * (i >> 2) + 4 * n + (i & 3); }

struct Unit { int pm, pn; };
struct Gemm { const bf16_t* A; const bf16_t* Bt; int M, N, K; };

struct StaticOrder {
    int nM, nN, nwg, G, c;
    __host__ __device__ void init(int M, int N, int G_, int c_) { nM = M / BM; nN = N / BM; nwg = nM * nN; G = G_; c = c_; }
    __host__ __device__ bool next(int i, Unit& u) const {
        const long L = (long)i * G + c; if (L >= nwg) return false;
        int wgid = (int)L; { const int q = nwg / NXCD, r = nwg % NXCD, xcd = wgid % NXCD, off = wgid / NXCD; wgid = (xcd < r ? xcd * (q + 1) : r * (q + 1) + (xcd - r) * q) + off; }
        const int nig = WGM * nN, gid = wgid / nig, fm = gid * WGM, gsz = (nM - fm) < WGM ? (nM - fm) : WGM;
        u.pm = fm + ((wgid % nig) % gsz); u.pn = (wgid % nig) / gsz; return true;
    }
    __device__ __forceinline__ void a_ready(const Unit&) const {}
    __device__ __forceinline__ void done(const Unit&) const {}
};

typedef float f32x2c_t __attribute__((ext_vector_type(2))); typedef __bf16 bf16x2c_t __attribute__((ext_vector_type(2)));
__device__ __forceinline__ unsigned cvt_pk_bf16(float lo, float hi) { f32x2c_t v = {lo, hi}; bf16x2c_t b = __builtin_convertvector(v, bf16x2c_t); return __builtin_bit_cast(unsigned, b); }
typedef float f32x2 __attribute__((ext_vector_type(2)));
__device__ __forceinline__ f32x2 gelu_pk(f32x2 v) {
    const f32x2 av = __builtin_elementwise_abs(v), d = av * 0.2316418882f + 1.0f;
    f32x2 t; t.x = __builtin_amdgcn_rcpf(d.x); t.y = __builtin_amdgcn_rcpf(d.y);
    f32x2 q = t * 0.5307027145f + (-0.7265760135f); q = q * t + 0.7107068705f; q = q * t + (-0.142248368f); q = q * t + 0.127414796f; q = q * t;
    const f32x2 s = (v * v) * (-0.72134752044f);
    f32x2 e; e.x = __builtin_amdgcn_exp2f(s.x); e.y = __builtin_amdgcn_exp2f(s.y);
    const f32x2 m = v * (q * e), r = v - m;
    f32x2 o; o.x = v.x < 0.f ? m.x : r.x; o.y = v.y < 0.f ? m.y : r.y; return o;
}

__device__ __forceinline__ float bf2f(unsigned short h) { return __uint_as_float((unsigned)h << 16); }
__device__ __forceinline__ float sigm(float x) { return __builtin_amdgcn_rcpf(1.0f + __builtin_amdgcn_exp2f(-1.4426950408889634f * x)); }
__device__ __forceinline__ f32x4 gelu4(f32x4 v) { const f32x2 a = gelu_pk((f32x2){v[0], v[1]}), b = gelu_pk((f32x2){v[2], v[3]}); return (f32x4){a.x, a.y, b.x, b.y}; }
__device__ __forceinline__ float dot4(f32x4 v) { return (v[0] * v[0] + v[1] * v[1]) + (v[2] * v[2] + v[3] * v[3]); }

struct EpiProj {
    static constexpr bool PERM = true, AFTER_DRAIN = false;
    bf16_t* dst5; bf16_t* dstg; const float* rope; const float* gate_b; const float* gnorm; float* gvss; float qscale;
    template <int KIND> __device__ __forceinline__ void body(const f32x4 (&acc)[2][2][4][2], const Unit& u, int seg, int wr, int wc, int fr, int fq) const {
        const int colt = (u.pn & 3) * BM;
        const int row0 = u.pm * BM + wr * 64 + fr, col0 = colt + wc * 32 + 8 * fq;
        bf16_t* base = (seg < 5) ? dst5 + (size_t)seg * ((size_t)32768 * 1024) : dstg + (size_t)(seg - 5) * ((size_t)32768 * 1024);
        const float sc = (seg == 0) ? qscale : 1.f;
        const bool rotw = (KIND == 0) && ((wc & 1) == 0);
        f32x4 cv[2][2];
        if (KIND == 3 || KIND == 4) { const float* p = (KIND == 3) ? gnorm : gate_b + (seg - 5) * 1024;
#pragma unroll
            for (int bj = 0; bj < 2; ++bj)
#pragma unroll
                for (int n = 0; n < 2; ++n) cv[bj][n] = *(const f32x4*)(p + col0 + bj * HALF + 4 * n); }
#pragma unroll
        for (int ai = 0; ai < 2; ++ai)
#pragma unroll
            for (int m = 0; m < 4; ++m) {
                const int row = row0 + ai * HALF + m * 16;
                f32x4 cs0, cs1, sn0, sn1;
                if (KIND == 0) { if (rotw) { const f32x4* rp = (const f32x4*)(rope + (size_t)row * 16); cs0 = rp[0]; cs1 = rp[1]; sn0 = rp[2]; sn1 = rp[3]; } }
                float ss = 0.f;
                bf16_t* rowp = base + (size_t)row * 1024 + col0;
#pragma unroll
                for (int bj = 0; bj < 2; ++bj) {
                    f32x4 v0 = acc[ai][bj][m][0], v1 = acc[ai][bj][m][1];
                    if (KIND == 0) {
                        if (rotw) { f32x4 p0, p1;
#pragma unroll
                            for (int i = 0; i < 4; ++i) { p0[i] = __shfl_xor(v0[i], 16); p1[i] = __shfl_xor(v1[i], 16); }
                            if (fq < 2) { const float sg = (fq == 0) ? -1.f : 1.f; v0 = v0 * cs0 + (p0 * sg) * sn0; v1 = v1 * cs1 + (p1 * sg) * sn1; } }
                        v0 = v0 * sc; v1 = v1 * sc;
                    }
                    if (KIND == 2 || KIND == 3) { v0 = gelu4(v0); v1 = gelu4(v1); }
                    if (KIND == 3) { ss += dot4(v0) + dot4(v1); v0 = v0 * cv[bj][0]; v1 = v1 * cv[bj][1]; }
                    if (KIND == 4) { v0 = v0 + cv[bj][0]; v1 = v1 + cv[bj][1];
#pragma unroll
                        for (int i = 0; i < 4; ++i) { v0[i] = sigm(v0[i]); v1[i] = sigm(v1[i]); } }
                    u32x4 w; w.x = cvt_pk_bf16(v0[0], v0[1]); w.y = cvt_pk_bf16(v0[2], v0[3]); w.z = cvt_pk_bf16(v1[0], v1[1]); w.w = cvt_pk_bf16(v1[2], v1[3]);
                    *(u32x4*)(rowp + bj * HALF) = w;
                }
                if (KIND == 3) { ss += __shfl_xor(ss, 16); ss += __shfl_xor(ss, 32); if (fq == 0) __hip_atomic_store(gvss + (size_t)row * 16 + (u.pn & 3) * 4 + wc, ss, __ATOMIC_RELAXED, __HIP_MEMORY_SCOPE_AGENT); }
            }
    }
    __device__ __forceinline__ void operator()(const f32x4 (&acc)[2][2][4][2], const Unit& u, int wr, int wc, int fr, int fq) const {
        const int seg = u.pn >> 2;
#if EPI_PLAIN
        body<1>(acc, u, seg, wr, wc, fr, fq); return;
#endif
        if (seg <= 1) body<0>(acc, u, seg, wr, wc, fr, fq);
        else if (seg == 2) body<1>(acc, u, seg, wr, wc, fr, fq);
        else if (seg == 3) body<2>(acc, u, seg, wr, wc, fr, fq);
        else if (seg == 4) body<3>(acc, u, seg, wr, wc, fr, fq);
        else body<4>(acc, u, seg, wr, wc, fr, fq);
    }
};

struct EpiResid {
    static constexpr bool PERM = false, AFTER_DRAIN = false;
    const float* base; float* out; bf16_t* xb; float* ss;
    __device__ __forceinline__ void operator()(const f32x4 (&acc)[2][2][4][2], const Unit& u, int wr, int wc, int fr, int fq) const {
        typedef unsigned u32x2v __attribute__((ext_vector_type(2)));
        const int row0 = u.pm * BM + wr * 64 + fr, col0 = u.pn * BM + wc * 32 + 4 * fq;
#pragma unroll
        for (int ai = 0; ai < 2; ++ai)
#pragma unroll
            for (int m = 0; m < 4; ++m) {
                const int row = row0 + ai * HALF + m * 16; const size_t off = (size_t)row * 1024 + col0; float s = 0.f;
#pragma unroll
                for (int bj = 0; bj < 2; ++bj)
#pragma unroll
                    for (int n = 0; n < 2; ++n) {
                        const f32x4 bs = *(const f32x4*)(base + off + bj * HALF + n * 16); const f32x4 o = bs + acc[ai][bj][m][n];
                        *(f32x4*)(out + off + bj * HALF + n * 16) = o; s += dot4(o);
                        if (xb) { u32x2v w; w.x = cvt_pk_bf16(o[0], o[1]); w.y = cvt_pk_bf16(o[2], o[3]); *(u32x2v*)(xb + off + bj * HALF + n * 16) = w; }
                    }
                s += __shfl_xor(s, 16); s += __shfl_xor(s, 32);
                if (fq == 0) __hip_atomic_store(ss + (size_t)row * 16 + u.pn * 4 + wc, s, __ATOMIC_RELAXED, __HIP_MEMORY_SCOPE_AGENT);
                if (m & 1) asm volatile("" ::: "memory");
            }
    }
};

struct EpiSwiglu {
    static constexpr bool PERM = true, AFTER_DRAIN = false;
    bf16_t* act; const float* ss; int ldc;
    __device__ __forceinline__ void operator()(const f32x4 (&acc)[2][2][4][2], const Unit& u, int wr, int wc, int fr, int fq) const {
        const int row0 = u.pm * BM + wr * 64 + fr, col0 = u.pn * HALF + wc * 32 + 8 * fq;
#pragma unroll
        for (int ai = 0; ai < 2; ++ai)
#pragma unroll
            for (int m = 0; m < 4; ++m) {
                const int row = row0 + ai * HALF + m * 16;
                const f32x4* sp = (const f32x4*)(ss + (size_t)row * 16); const f32x4 t = (sp[0] + sp[1]) + (sp[2] + sp[3]);
                const float rinv = __builtin_amdgcn_rsqf(((t[0] + t[1]) + (t[2] + t[3])) * (1.0f / 1024.0f) + 1e-6f);
                f32x4 h[2];
#pragma unroll
                for (int n = 0; n < 2; ++n) { const f32x4 a = acc[ai][0][m][n] * rinv, b = acc[ai][1][m][n] * rinv;
#pragma unroll
                    for (int i = 0; i < 4; ++i) h[n][i] = a[i] * sigm(a[i]) * b[i]; }
                u32x4 w; w.x = cvt_pk_bf16(h[0][0], h[0][1]); w.y = cvt_pk_bf16(h[0][2], h[0][3]); w.z = cvt_pk_bf16(h[1][0], h[1][1]); w.w = cvt_pk_bf16(h[1][2], h[1][3]);
                *(u32x4*)(act + (size_t)row * ldc + col0) = w;
            }
    }
};

template <class Epi, class Sched, bool ALIGN_EPI = false, bool SP2 = false>
__device__ __forceinline__ void gemm_phase(PG8_LAS unsigned char* lds, const Gemm g, const Sched& S, const Epi& E) {
    const int tid = threadIdx.x, wid = __builtin_amdgcn_readfirstlane(tid >> 6), lane = tid & 63, wr = wid >> 2, wc = wid & 3, fr = lane & 15, fq = lane >> 4;
    const int K = g.K, nt = K / BK;
    unsigned voffA[2], voffB[2];
#pragma unroll
    for (int i = 0; i < 2; ++i) { int R, C; stage_rc(tid * 16 + i * 8192, R, C); const int Rb = Epi::PERM ? ((R & ~31) + perm32(R & 31)) : R;
        voffA[i] = (unsigned)(R * K + C) * 2u; voffB[i] = (unsigned)(Rb * K + C) * 2u; }
    const size_t kstep = (size_t)(BK * 2);
    const size_t hstep = (size_t)HALF * K * 2;
    const size_t tstep = 2 * hstep;
    const unsigned ldsw = (unsigned)wid * 1024u;
    const int aoff = lds_byte(wr * 64 + fr, fq * 8), boff = lds_byte(wc * 32 + fr, fq * 8);
#define PG8_SA(b, h) (((b) * 2 + (h)) * HTB)
#define PG8_SB(b, h) ((4 + (b) * 2 + (h)) * HTB)
#define PG8_STAGE(bufoff, gbase, voff) do { _Pragma("unroll") for (int _i = 0; _i < 2; ++_i) \
        __builtin_amdgcn_global_load_lds((const unsigned*)((const char*)(gbase) + (voff)[_i]), (PG8_LAS unsigned*)(lds + (bufoff) + ldsw + _i * 8192), 16, 0, 0); } while (0)
#define PG8_LDA(dst, b, h) do { _Pragma("unroll") for (int m = 0; m < 4; ++m) _Pragma("unroll") for (int k = 0; k < 2; ++k) dst[m][k] = *(const PG8_LAS bf16x8*)(lds + PG8_SA(b, h) + aoff + m * 2048 + k * 1024); } while (0)
#define PG8_LDB(dst, b, h) do { _Pragma("unroll") for (int n = 0; n < 2; ++n) _Pragma("unroll") for (int k = 0; k < 2; ++k) dst[n][k] = *(const PG8_LAS bf16x8*)(lds + PG8_SB(b, h) + boff + n * 2048 + k * 1024); } while (0)
#define PG8_MMA(ai, bj, At, Bt) do { __builtin_amdgcn_s_setprio(1); _Pragma("unroll") for (int m = 0; m < 4; ++m) _Pragma("unroll") for (int n = 0; n < 2; ++n) _Pragma("unroll") for (int k = 0; k < 2; ++k) \
        acc[ai][bj][m][n] = __builtin_amdgcn_mfma_f32_16x16x32_bf16(Bt[n][k], At[m][k], acc[ai][bj][m][n], 0, 0, 0); __builtin_amdgcn_s_setprio(0); } while (0)
#define PG8_WAIT_V(n) asm volatile("s_waitcnt vmcnt(" #n ")" ::: "memory")
#define PG8_WAIT_L(n) asm volatile("s_waitcnt lgkmcnt(" #n ")" ::: "memory")
#define PG8_BAR __builtin_amdgcn_s_barrier()
#define PG8_SCHED __builtin_amdgcn_sched_barrier(0)
    Unit cur, nxt; int ui = 0;
    if (!S.next(0, cur)) return;
    f32x4 acc[2][2][4][2];
#pragma unroll
    for (int a = 0; a < 2; ++a)
#pragma unroll
        for (int b = 0; b < 2; ++b)
#pragma unroll
            for (int m = 0; m < 4; ++m)
#pragma unroll
                for (int n = 0; n < 2; ++n) acc[a][b][m][n] = (f32x4){0.f, 0.f, 0.f, 0.f};
    bf16x8 At[4][2], B0[2][2], B1[2][2];
    const char* cA = (const char*)g.A + (size_t)cur.pm * tstep; const char* cB = (const char*)g.Bt + (size_t)cur.pn * tstep;
    S.a_ready(cur);
    if constexpr (SP2) {
        PG8_STAGE(PG8_SB(0, 0), cB, voffB); PG8_STAGE(PG8_SB(0, 1), cB + hstep, voffB); PG8_STAGE(PG8_SA(0, 0), cA, voffA); PG8_STAGE(PG8_SA(0, 1), cA + hstep, voffA);
        if (wr == 1) PG8_BAR;
        PG8_WAIT_V(2); PG8_BAR;
        PG8_STAGE(PG8_SB(1, 0), cB + kstep, voffB); PG8_STAGE(PG8_SA(1, 0), cA + kstep, voffA); PG8_STAGE(PG8_SB(1, 1), cB + hstep + kstep, voffB);
        PG8_WAIT_V(6); PG8_BAR;
    } else {
        PG8_STAGE(PG8_SB(0, 0), cB, voffB); PG8_STAGE(PG8_SA(0, 0), cA, voffA); PG8_STAGE(PG8_SB(0, 1), cB + hstep, voffB); PG8_STAGE(PG8_SA(0, 1), cA + hstep, voffA);
        if (wr == 1) PG8_BAR;
        PG8_WAIT_V(4); PG8_BAR;
        PG8_STAGE(PG8_SB(1, 0), cB + kstep, voffB); PG8_STAGE(PG8_SA(1, 0), cA + kstep, voffA); PG8_STAGE(PG8_SB(1, 1), cB + hstep + kstep, voffB);
        PG8_WAIT_V(6); PG8_BAR;
    }
    for (;;) {
        const bool has_next = S.next(ui + 1, nxt);
        const char* nA = has_next ? (const char*)g.A + (size_t)nxt.pm * tstep : cA; const char* nB = has_next ? (const char*)g.Bt + (size_t)nxt.pn * tstep : cB;
        for (int t = 0; t < nt; t += 2) {
            const bool last = (t == nt - 2);
            const char* a1 = cA + (size_t)(t + 1) * kstep;
            const char* a2 = last ? nA : cA + (size_t)(t + 2) * kstep; const char* b2 = last ? nB : cB + (size_t)(t + 2) * kstep;
            const char* a3 = a2 + kstep; const char* b3 = b2 + kstep;
            if (last && has_next) S.a_ready(nxt);
            if constexpr (SP2) {
            PG8_LDB(B0, 0, 0); PG8_LDB(B1, 0, 1); PG8_SCHED; PG8_LDA(At, 0, 0); PG8_STAGE(PG8_SA(1, 1), a1 + hstep, voffA);
            PG8_WAIT_V(8); PG8_WAIT_L(0); PG8_BAR; PG8_MMA(0, 0, At, B0); PG8_MMA(0, 1, At, B1); PG8_BAR; PG8_SCHED;
            PG8_LDA(At, 0, 1); PG8_STAGE(PG8_SB(0, 0), b2, voffB); PG8_STAGE(PG8_SB(0, 1), b2 + hstep, voffB); PG8_STAGE(PG8_SA(0, 0), a2, voffA);
            PG8_WAIT_V(8); PG8_WAIT_L(0); PG8_BAR; PG8_MMA(1, 0, At, B0); PG8_MMA(1, 1, At, B1); PG8_BAR; PG8_SCHED;
            PG8_LDB(B0, 1, 0); PG8_LDB(B1, 1, 1); PG8_SCHED; PG8_LDA(At, 1, 0); PG8_STAGE(PG8_SA(0, 1), a2 + hstep, voffA);
            PG8_WAIT_V(8); PG8_WAIT_L(0); PG8_BAR; PG8_MMA(0, 0, At, B0); PG8_MMA(0, 1, At, B1); PG8_BAR; PG8_SCHED;
            PG8_LDA(At, 1, 1); PG8_STAGE(PG8_SB(1, 0), b3, voffB); PG8_STAGE(PG8_SB(1, 1), b3 + hstep, voffB); PG8_STAGE(PG8_SA(1, 0), a3, voffA);
            PG8_WAIT_V(8); PG8_WAIT_L(0); PG8_BAR; PG8_MMA(1, 0, At, B0); PG8_MMA(1, 1, At, B1); PG8_BAR; PG8_SCHED;
            } else {
            PG8_LDB(B0, 0, 0); PG8_SCHED; PG8_LDA(At, 0, 0); PG8_STAGE(PG8_SA(1, 1), a1 + hstep, voffA);
            PG8_WAIT_L(8); PG8_BAR; PG8_WAIT_L(0); PG8_MMA(0, 0, At, B0); PG8_BAR; PG8_SCHED;
            PG8_LDB(B1, 0, 1); PG8_STAGE(PG8_SB(0, 0), b2, voffB);
            PG8_BAR; PG8_WAIT_L(0); PG8_MMA(0, 1, At, B1); PG8_BAR;
            PG8_LDA(At, 0, 1); PG8_STAGE(PG8_SA(0, 0), a2, voffA);
            PG8_BAR; PG8_WAIT_L(0); PG8_MMA(1, 0, At, B0); PG8_BAR; PG8_SCHED;
            PG8_STAGE(PG8_SB(0, 1), b2 + hstep, voffB);
            PG8_WAIT_V(6); PG8_BAR; PG8_MMA(1, 1, At, B1); PG8_BAR;
            PG8_LDB(B0, 1, 0); PG8_SCHED; PG8_LDA(At, 1, 0); PG8_STAGE(PG8_SA(0, 1), a2 + hstep, voffA);
            PG8_WAIT_L(8); PG8_BAR; PG8_WAIT_L(0); PG8_MMA(0, 0, At, B0); PG8_BAR; PG8_SCHED;
            PG8_LDB(B1, 1, 1); PG8_STAGE(PG8_SB(1, 0), b3, voffB);
            PG8_BAR; PG8_WAIT_L(0); PG8_MMA(0, 1, At, B1); PG8_BAR;
            PG8_LDA(At, 1, 1); PG8_STAGE(PG8_SA(1, 0), a3, voffA);
            PG8_BAR; PG8_WAIT_L(0); PG8_MMA(1, 0, At, B0); PG8_BAR; PG8_SCHED;
            PG8_STAGE(PG8_SB(1, 1), b3 + hstep, voffB);
            PG8_WAIT_V(6); PG8_BAR; PG8_MMA(1, 1, At, B1); PG8_BAR;
            }
        }
        if constexpr (ALIGN_EPI) { if (wr == 0) PG8_BAR; }
        if constexpr (!Epi::AFTER_DRAIN) { E(acc, cur, wr, wc, fr, fq); S.done(cur); }
        if (!has_next) break;
#pragma unroll
        for (int a = 0; a < 2; ++a)
#pragma unroll
            for (int b = 0; b < 2; ++b)
#pragma unroll
                for (int m = 0; m < 4; ++m)
#pragma unroll
                    for (int n = 0; n < 2; ++n) acc[a][b][m][n] = (f32x4){0.f, 0.f, 0.f, 0.f};
        cur = nxt; cA = nA; cB = nB; ++ui;
        if constexpr (ALIGN_EPI) { if (wr == 1) PG8_BAR; }
    }
    PG8_WAIT_V(0);
    if constexpr (!ALIGN_EPI) { if (wr == 0) PG8_BAR; }
    PG8_BAR;
    if constexpr (Epi::AFTER_DRAIN) { E.fused(acc, cur, wr, wc, fr, fq, lds, wid, lane); S.done(cur); }
#undef PG8_SA
#undef PG8_SB
#undef PG8_STAGE
#undef PG8_LDA
#undef PG8_LDB
#undef PG8_MMA
#undef PG8_WAIT_V
#undef PG8_WAIT_L
#undef PG8_BAR
#undef PG8_SCHED
}
}
namespace dattn {
#define DLAS __attribute__((address_space(3)))
typedef unsigned short bf16_t;
using bf16x8 = __attribute__((ext_vector_type(8))) short;
using s16x4 = __attribute__((ext_vector_type(4))) short;
using f32x16 = __attribute__((ext_vector_type(16))) float;
using f32x4 = __attribute__((ext_vector_type(4))) float;
using u32x4 = __attribute__((ext_vector_type(4))) unsigned;
typedef short v4i16_t __attribute__((ext_vector_type(4)));
constexpr int SEQ = 2048, DM = 1024, QB = 128, KVBLK = 64;
constexpr int SLOTB = 32768, OFF_K1 = 0, OFF_K2 = 8192, OFF_V = 16384;
constexpr float C2 = 0.125f * 1.4426950408889634f;
constexpr float THR = 8.0f;
__device__ __forceinline__ int crow(int r, int hi) { return (r & 3) + 8 * (r >> 2) + 4 * hi; }
__device__ __forceinline__ void glds16(const void* gsrc, unsigned lds_dst) { unsigned keep;
    asm volatile("s_mov_b32 %0, m0\n\ts_mov_b32 m0, %2\n\ts_nop 0\n\tglobal_load_lds_dwordx4 %1, off\n\ts_mov_b32 m0, %0" : "=&s"(keep) : "v"(gsrc), "s"(lds_dst) : "memory"); }
__device__ __forceinline__ s16x4 vtr(const DLAS unsigned char* p) { return __builtin_bit_cast(s16x4, __builtin_amdgcn_ds_read_tr16_b64_v4i16((DLAS v4i16_t*)p)); }
__device__ __forceinline__ float bf2f(unsigned short h) { return __uint_as_float((unsigned)h << 16); }
typedef float f32x2_t __attribute__((ext_vector_type(2))); typedef __bf16 bf16x2_t __attribute__((ext_vector_type(2)));
__device__ __forceinline__ unsigned cvtpk(float lo, float hi) { f32x2_t v = {lo, hi}; bf16x2_t b = __builtin_convertvector(v, bf16x2_t); return __builtin_bit_cast(unsigned, b); }
#define MX3(a, b, c) __builtin_fmaxf(__builtin_fmaxf((a), (b)), (c))
__device__ __forceinline__ float rowmax(const f32x16& p0, const f32x16& p1) {
    float a = MX3(p0[0], p0[1], p1[0]), b = MX3(p0[2], p0[3], p1[1]); a = MX3(a, p1[2], p1[3]);
#pragma unroll
    for (int r = 4; r < 16; r += 4) { a = MX3(a, p0[r], p0[r + 1]); b = MX3(b, p0[r + 2], p0[r + 3]); a = MX3(a, p1[r], p1[r + 1]); b = MX3(b, p1[r + 2], p1[r + 3]); }
    float m = __builtin_fmaxf(a, b); auto rr = __builtin_amdgcn_permlane32_swap(__float_as_uint(m), __float_as_uint(m), false, false);
    return __builtin_fmaxf(__uint_as_float(rr[0]), __uint_as_float(rr[1])); }
#define MFMA32(a, b, c) __builtin_amdgcn_mfma_f32_32x32x16_bf16(a, b, c, 0, 0, 0)
#define WAIT_BAR(N) asm volatile("s_waitcnt vmcnt(" #N ") lgkmcnt(0)\n\ts_barrier" ::: "memory")
#define BAR_ALL() asm volatile("s_waitcnt vmcnt(0) lgkmcnt(0)\n\ts_barrier" ::: "memory")

__device__ __forceinline__ void unit(int b, int h, int qb, const bf16_t* Q, const bf16_t* K, const bf16_t* V, const bf16_t* G0, const bf16_t* GM, bf16_t* MERGED,
                                     const float* subln_g, float lam, DLAS unsigned char* shm, DLAS float* wsf_base) {
    const int tid = threadIdx.x, lane = tid & 63, r32 = lane & 31, hi = lane >> 5; const int wid = __builtin_amdgcn_readfirstlane(tid >> 6);
    const int map = wid >> 2, rq = wid & 3;
    const long rowbase = (long)b * SEQ; const int q0 = qb * QB;
    const int NT = 2 * qb + 2, myNT = (rq < 2) ? NT - 1 : NT;
    const bf16_t* Qw = Q + (rowbase + q0 + rq * 32) * DM + h * 128 + map * 64;
    const bf16_t* Kh = K + rowbase * DM + h * 128; const bf16_t* Vh = V + rowbase * DM + h * 128;
    const unsigned lds0 = (unsigned)(uintptr_t)shm;
    DLAS float* wsf = wsf_base + wid * 64;
    const bf16_t* ksrc1 = Kh + (long)lane * DM + wid * 8; const bf16_t* ksrc2 = ksrc1 + 64;
    const bf16_t* vsrcA = Vh + (long)(16 * (wid & 3) + (lane >> 2)) * DM + (wid >> 2) * 32 + (lane & 3) * 8; const bf16_t* vsrcB = vsrcA + 64;
    const unsigned dK1 = lds0 + OFF_K1 + wid * 1024, dK2 = lds0 + OFF_K2 + wid * 1024, dVA = lds0 + OFF_V + wid * 1024, dVB = lds0 + OFF_V + (wid + 8) * 1024;
#define RFL(x) ((unsigned)__builtin_amdgcn_readfirstlane(x))
#define DMA_T(t, slot) do { const long go_ = (long)(t) * KVBLK * DM; glds16(ksrc1 + go_, RFL(dK1 + (slot))); glds16(ksrc2 + go_, RFL(dK2 + (slot))); glds16(vsrcA + go_, RFL(dVA + (slot))); glds16(vsrcB + go_, RFL(dVB + (slot))); } while (0)
    const DLAS unsigned char* kp0 = shm + (map ? OFF_K2 : OFF_K1) + hi * 1024 + r32 * 16;
    const DLAS unsigned char* vp0 = shm + OFF_V + ((lane >> 4) & 1) * 32 + (lane & 3) * 8 + (4 * hi + ((lane & 15) >> 2)) * 64;
    bf16x8 qr[4];
#pragma unroll
    for (int d0 = 0; d0 < 4; ++d0) qr[d0] = *reinterpret_cast<const bf16x8*>(Qw + (long)r32 * DM + d0 * 16 + hi * 8);
    DMA_T(0, 0); DMA_T(1, SLOTB);
    float mref = 0.f, l_reg = 0.f; f32x16 o[4]; o[0] = f32x16{}; o[1] = f32x16{}; o[2] = f32x16{}; o[3] = f32x16{};
    f32x16 negm = f32x16{};
    int sl_cur = 0, sl_nn = 2 * SLOTB;
    for (int t = 0; t < NT; ++t) {
        if (t + 1 < NT) { WAIT_BAR(4); } else { WAIT_BAR(0); }
        if (t + 2 < NT) DMA_T(t + 2, sl_nn);
        if (t < myNT) {
            const DLAS unsigned char* kp = kp0 + sl_cur; const DLAS unsigned char* vp = vp0 + sl_cur;
            f32x16 p0 = negm, p1 = negm;
#pragma unroll
            for (int d0 = 0; d0 < 4; ++d0) {
                const bf16x8 k0 = *(const DLAS bf16x8*)(kp + d0 * 2048), k1 = *(const DLAS bf16x8*)(kp + d0 * 2048 + 512);
                p0 = MFMA32(k0, qr[d0], p0); p1 = MFMA32(k1, qr[d0], p1);
            }
            const float rm = rowmax(p0, p1);
            if (t == 0 || __any(rm > THR)) {
                const float dl = (t == 0) ? rm : __builtin_fmaxf(rm, 0.f);
                mref += dl;
#pragma unroll
                for (int r = 0; r < 16; ++r) { p0[r] -= dl; p1[r] -= dl; }
#pragma unroll
                for (int r = 0; r < 16; ++r) negm[r] = -mref;
                if (t != 0) {
                    const float f = __builtin_amdgcn_exp2f(-dl); l_reg *= f;
                    if (hi == 0) wsf[r32] = f;
                    asm volatile("s_waitcnt lgkmcnt(0)" ::: "memory");
                    float a[16];
#pragma unroll
                    for (int r = 0; r < 16; ++r) a[r] = wsf[crow(r, hi)];
#pragma unroll
                    for (int d = 0; d < 4; ++d)
#pragma unroll
                        for (int r = 0; r < 16; ++r) o[d][r] *= a[r];
                }
            }
            float sacc = 0.f;
#pragma unroll
            for (int r = 0; r < 16; ++r) { p0[r] = __builtin_amdgcn_exp2f(p0[r]); p1[r] = __builtin_amdgcn_exp2f(p1[r]); sacc += p0[r] + p1[r]; }
            l_reg += sacc;
            u32x4 pw[4];
            pw[0] = (u32x4){cvtpk(p0[0], p0[1]), cvtpk(p0[2], p0[3]), cvtpk(p0[4], p0[5]), cvtpk(p0[6], p0[7])};
            pw[1] = (u32x4){cvtpk(p0[8], p0[9]), cvtpk(p0[10], p0[11]), cvtpk(p0[12], p0[13]), cvtpk(p0[14], p0[15])};
            pw[2] = (u32x4){cvtpk(p1[0], p1[1]), cvtpk(p1[2], p1[3]), cvtpk(p1[4], p1[5]), cvtpk(p1[6], p1[7])};
            pw[3] = (u32x4){cvtpk(p1[8], p1[9]), cvtpk(p1[10], p1[11]), cvtpk(p1[12], p1[13]), cvtpk(p1[14], p1[15])};
#pragma unroll
            for (int dq = 0; dq < 4; ++dq) {
#pragma unroll
                for (int ks = 0; ks < 4; ++ks) {
                    const s16x4 lo = vtr(vp + dq * 4096 + ks * 1024), hh = vtr(vp + dq * 4096 + ks * 1024 + 512);
                    const bf16x8 vf = (bf16x8){lo[0], lo[1], lo[2], lo[3], hh[0], hh[1], hh[2], hh[3]};
                    o[dq] = MFMA32(__builtin_bit_cast(bf16x8, pw[ks]), vf, o[dq]);
                }
            }
        }
        sl_cur = (sl_cur == 2 * SLOTB) ? 0 : sl_cur + SLOTB; sl_nn = (sl_nn == 2 * SLOTB) ? 0 : sl_nn + SLOTB;
    }
    { auto rr = __builtin_amdgcn_permlane32_swap(__float_as_uint(l_reg), __float_as_uint(l_reg), false, false); l_reg = __uint_as_float(rr[0]) + __uint_as_float(rr[1]); }
    if (hi == 0) wsf[32 + r32] = l_reg;
    asm volatile("s_waitcnt lgkmcnt(0)" ::: "memory");
    float rli[16];
#pragma unroll
    for (int r = 0; r < 16; ++r) rli[r] = __builtin_amdgcn_rcpf(wsf[32 + crow(r, hi)]);
    BAR_ALL();
    DLAS float* st = (DLAS float*)shm;
#pragma unroll
    for (int r = 0; r < 16; ++r) { const int row = map * 128 + rq * 32 + crow(r, hi);
#pragma unroll
        for (int dq = 0; dq < 4; ++dq) st[row * 128 + dq * 32 + r32] = o[dq][r] * rli[r]; }
    BAR_ALL();
#pragma unroll
    for (int ps = 0; ps < 4; ++ps) {
        const int item = ps * 512 + tid, row = item >> 4, ch = item & 15;
        const DLAS f32x4* p1 = (const DLAS f32x4*)(st + row * 128 + ch * 8); const DLAS f32x4* p2 = (const DLAS f32x4*)(st + 16384 + row * 128 + ch * 8);
        const f32x4 o0 = p1[0] - p2[0] * lam, o1 = p1[1] - p2[1] * lam;
        float ss = ((o0[0] * o0[0] + o0[1] * o0[1]) + (o0[2] * o0[2] + o0[3] * o0[3])) + ((o1[0] * o1[0] + o1[1] * o1[1]) + (o1[2] * o1[2] + o1[3] * o1[3]));
        ss += __shfl_xor(ss, 1); ss += __shfl_xor(ss, 2); ss += __shfl_xor(ss, 4); ss += __shfl_xor(ss, 8);
        const float rinv = __builtin_amdgcn_rsqf(ss * (1.0f / 128.0f) + 1e-5f) * 0.8f;
        const size_t gi = (size_t)(rowbase + q0 + row) * DM + h * 128 + ch * 8;
        const u32x4 g0v = *(const u32x4*)(G0 + gi), gmv = *(const u32x4*)(GM + gi);
        const f32x4 sg0 = *(const f32x4*)(subln_g + ch * 8), sg1 = *(const f32x4*)(subln_g + ch * 8 + 4);
        float y[8];
#pragma unroll
        for (int i = 0; i < 4; ++i) { y[i] = o0[i] * rinv * sg0[i]; y[4 + i] = o1[i] * rinv * sg1[i]; }
        u32x4 w;
#pragma unroll
        for (int i = 0; i < 4; ++i) {
            const unsigned gg = g0v[i], mm = gmv[i];
            const float lo = __uint_as_float(gg << 16) * y[2 * i] + __uint_as_float(mm << 16), hh = __uint_as_float(gg & 0xffff0000u) * y[2 * i + 1] + __uint_as_float(mm & 0xffff0000u);
            w[i] = cvtpk(lo, hh);
        }
        *(u32x4*)(MERGED + gi) = w;
    }
    BAR_ALL();
#undef DMA_T
#undef RFL
}

__device__ __forceinline__ void gmlp_unit(int b, int n, int g, const bf16_t* GV, const bf16_t* GU, const bf16_t* G1, const float* gvss, const bf16_t* Wp, const float* bs, bf16_t* GM,
                                          DLAS unsigned char* shm) {
    const int tid = threadIdx.x, lane = tid & 63, r32 = lane & 31, hi = lane >> 5; const int wid = __builtin_amdgcn_readfirstlane(tid >> 6);
    const long rowbase = (long)b * SEQ + n * 128;
    DLAS float* rin = (DLAS float*)(shm + 32768);
    if (tid < 128) { const f32x4* sp = (const f32x4*)(gvss + (size_t)(rowbase + tid) * 16); const f32x4 t = (sp[0] + sp[1]) + (sp[2] + sp[3]);
        rin[tid] = __builtin_amdgcn_rsqf(((t[0] + t[1]) + (t[2] + t[3])) * (1.0f / 1024.0f) + 1e-6f); }
    __syncthreads();
#pragma unroll
    for (int it = 0; it < 4; ++it) {
        const int item = it * 512 + tid, row = item >> 4, c16 = item & 15;
        const u32x4 v = *(const u32x4*)(GV + (size_t)(rowbase + row) * DM + g * 128 + c16 * 8); const float ri = rin[row];
        u32x4 w;
#pragma unroll
        for (int i = 0; i < 4; ++i) w[i] = cvtpk(__uint_as_float(v[i] << 16) * ri, __uint_as_float(v[i] & 0xffff0000u) * ri);
        *(DLAS u32x4*)(shm + (c16 >> 2) * 8192 + row * 64 + (c16 & 3) * 16) = w;
    }
    __syncthreads();
    const int ib = wid >> 1, cb0 = 2 * (wid & 1), nks = (ib < 2) ? 4 : 8;
    const DLAS unsigned char* vp0 = shm + ((lane >> 4) & 1) * 32 + (lane & 3) * 8 + (4 * hi + ((lane & 15) >> 2)) * 64;
    const bf16_t* wrow = Wp + ((size_t)(g * 128 + ib * 32 + r32)) * 128 + hi * 8;
    f32x16 acc[2]; acc[0] = f32x16{}; acc[1] = f32x16{};
    for (int ks = 0; ks < nks; ++ks) {
        const bf16x8 a = *(const bf16x8*)(wrow + ks * 16);
#pragma unroll
        for (int c = 0; c < 2; ++c) {
            const s16x4 lo = vtr(vp0 + (cb0 + c) * 8192 + ks * 1024), hh = vtr(vp0 + (cb0 + c) * 8192 + ks * 1024 + 512);
            const bf16x8 vf = (bf16x8){lo[0], lo[1], lo[2], lo[3], hh[0], hh[1], hh[2], hh[3]};
            acc[c] = MFMA32(a, vf, acc[c]);
        }
    }
#pragma unroll
    for (int c = 0; c < 2; ++c)
#pragma unroll
        for (int r = 0; r < 16; ++r) {
            const int i = ib * 32 + crow(r, hi); const size_t idx = (size_t)(rowbase + i) * DM + g * 128 + (cb0 + c) * 32 + r32;
            const float mixed = acc[c][r] + bs[g * 128 + i];
            const float gm = bf2f(GU[idx]) * mixed * bf2f(G1[idx]);
            GM[idx] = (bf16_t)(cvtpk(gm, 0.f) & 0xffffu);
        }
    __syncthreads();
}
#undef MX3
#undef MFMA32
#undef WAIT_BAR
#undef BAR_ALL
}

#ifndef STOP_AFTER
#define STOP_AFTER 0
#endif
constexpr int NWAVES = 8;
constexpr int M = 16 * 2048, D = 1024, DIN = 7168, DFF = 2816;
constexpr size_t MiB = 1u << 20;
constexpr size_t WS_CTL = 0, CTL_ZERO_BYTES = 1 * MiB;
constexpr size_t WS_WIN = 2 * MiB, WS_WOUT = 16 * MiB, WS_WFFI = 18 * MiB, WS_WFFO = 29 * MiB, WS_WSP = 35 * MiB, WS_ROPE = 36 * MiB;
constexpr size_t WS_SS0 = 38 * MiB, WS_SS1 = 40 * MiB, WS_SS2 = 42 * MiB;
constexpr size_t WS_XN = 48 * MiB, WS_Q = 112 * MiB, WS_K = 176 * MiB, WS_V = 240 * MiB, WS_GU = 304 * MiB, WS_GV = 368 * MiB, WS_END = 432 * MiB;
static_assert(WS_WFFO + (size_t)D * DFF * 2 <= WS_WSP && WS_K + (size_t)M * DFF * 2 <= WS_GV, "d_ws map");
constexpr int CW_BAR = 4096;
constexpr int RING_OFF = 0, RING_BYTES = 131072;
constexpr int LDSCTL_OFF = RING_BYTES, MISC_OFF = LDSCTL_OFF + 320, WSF_OFF = LDSCTL_OFF + 4096;
constexpr int LDS_BYTES = 147456;
#define GAS __attribute__((address_space(1)))
#define LAS __attribute__((address_space(3)))
typedef unsigned short bf16;
typedef unsigned v4u __attribute__((ext_vector_type(4)));
typedef float f32x4 __attribute__((ext_vector_type(4)));
typedef short bf16x8 __attribute__((ext_vector_type(8)));
typedef GAS unsigned gu32;
typedef GAS unsigned long long gu64;
#define RLX_AGENT __ATOMIC_RELAXED, __HIP_MEMORY_SCOPE_AGENT
#define LDS_WAIT() asm volatile("s_waitcnt lgkmcnt(0)" ::: "memory")
#define VM_WAIT() asm volatile("s_waitcnt vmcnt(0)" ::: "memory")
__device__ __forceinline__ unsigned long long rt() { return __builtin_amdgcn_s_memrealtime(); }
__device__ __forceinline__ unsigned f2bf(float f) { unsigned u = __builtin_bit_cast(unsigned, f); return (u + 0x7fffu + ((u >> 16) & 1u)) >> 16; }
__device__ __forceinline__ unsigned pk2(float lo, float hi) { return f2bf(lo) | (f2bf(hi) << 16); }

#define XB_TMO      128
#define XB_XCNT(j)  (256  + 64 * (j))
#define XB_XSUB(j)  (1280 + 64 * (j))
#define XB_XGEN(j)  (2304 + 64 * (j))
#define XB_TOP      3328
#define XB_TOPGEN   3392
#define XCD_BAR_WORDS 3456
#define XB_SPIN_CAP (1u << 18)

__device__ __forceinline__ unsigned xb_ld(unsigned* p)              { return __hip_atomic_load(p, __ATOMIC_RELAXED, __HIP_MEMORY_SCOPE_AGENT); }
__device__ __forceinline__ unsigned xb_add(unsigned* p, unsigned v) { return __hip_atomic_fetch_add(p, v, __ATOMIC_RELAXED, __HIP_MEMORY_SCOPE_AGENT); }
__device__ __forceinline__ unsigned xb_xcc_id() { return (unsigned)__builtin_amdgcn_s_getreg((3 << 11) | 20) & 0xFu; }
#define XB_SPIN(cond, bar) do { unsigned _sp = 0; while (cond) { __builtin_amdgcn_s_sleep(1); \
    if ((++_sp & 255u) == 0u) { if (xb_ld(&(bar)[XB_TMO])) break; if (_sp > XB_SPIN_CAP) { atomicAdd(&(bar)[XB_TMO], 1u); break; } } } } while (0)

struct XcdBarrier {
    unsigned* bar; unsigned x;
    volatile LAS unsigned* st;
};

__device__ __forceinline__ XcdBarrier xcd_barrier_post(unsigned* bar, volatile LAS unsigned* st) {
    XcdBarrier b; b.bar = bar; b.x = xb_xcc_id(); b.st = st;
    if (threadIdx.x == 0) (void)xb_add(&bar[XB_XCNT(b.x)], 1u);
    return b;
}
__device__ __forceinline__ void xcd_barrier_complete(unsigned* bar, unsigned x, unsigned& nloc, unsigned& nx) {
    const unsigned G = gridDim.x * gridDim.y * gridDim.z;
    unsigned sum, cnt, mine, sp = 0u;
    for (;;) {
        sum = 0u; cnt = 0u; mine = 0u;
#pragma unroll
        for (unsigned j = 0; j < 16; ++j) { const unsigned c = xb_ld(&bar[XB_XCNT(j)]); sum += c; cnt += (c > 0u) ? 1u : 0u; mine = (j == x) ? c : mine; }
        if (sum == G) break;
        __builtin_amdgcn_s_sleep(1);
        if ((++sp & 255u) == 0u) { if (xb_ld(&bar[XB_TMO])) break; if (sp > XB_SPIN_CAP) { atomicAdd(&bar[XB_TMO], 1u); break; } }
    }
    nloc = mine > 0u ? mine : 1u; nx = cnt > 0u ? cnt : 1u;
}

__device__ __forceinline__ void xcd_barrier(const XcdBarrier& b) {
    asm volatile("s_waitcnt vmcnt(0)" ::: "memory");
    __syncthreads();
    if (threadIdx.x == 0) {
        unsigned* bar = b.bar;
        __builtin_amdgcn_s_waitcnt(0);
        unsigned nloc = b.st[0], nx = b.st[1];
        if (nloc == 0u) { xcd_barrier_complete(bar, b.x, nloc, nx); b.st[0] = nloc; b.st[1] = nx; }
        const unsigned old = xb_add(&bar[XB_XSUB(b.x)], 1u);
        const unsigned gen = old / nloc;
        if (old + 1u == (gen + 1u) * nloc) {
            __builtin_amdgcn_fence(__ATOMIC_RELEASE, "agent");
            asm volatile("s_waitcnt vmcnt(0)" ::: "memory");
            const unsigned og = xb_add(&bar[XB_TOP], 1u);
            const unsigned tg = og / nx;
            if (og + 1u == (tg + 1u) * nx) xb_add(&bar[XB_TOPGEN], 1u);
            else XB_SPIN(xb_ld(&bar[XB_TOPGEN]) == tg, bar);
            __builtin_amdgcn_fence(__ATOMIC_ACQUIRE, "agent");
            xb_add(&bar[XB_XGEN(b.x)], 1u);
            asm volatile("s_waitcnt vmcnt(0)" ::: "memory");
        } else {
            XB_SPIN(xb_ld(&bar[XB_XGEN(b.x)]) == gen, bar);
            __builtin_amdgcn_fence(__ATOMIC_ACQUIRE, "agent");
            asm volatile("s_waitcnt vmcnt(0)" ::: "memory");
        }
    }
    __syncthreads();
}
struct Frame {
    LAS unsigned char* lds;
    volatile LAS unsigned* MISC;
    gu32* ctl;
    int tid, lane, wave;
    int vcu, G;
};

__device__ __forceinline__ float wave_sum(float v) {
#pragma unroll
    for (int o = 1; o < 64; o <<= 1) v += __shfl_xor(v, o);
    return v;
}
__device__ __forceinline__ void p0_transpose_item(const float* W, int K, int N, bf16* WT, int n0d, int n0s, int k0, const float* kscale, LAS float* scr, int lane) {
#pragma unroll 8
    for (int i = 0; i < 32; ++i) { const int kk = 2 * i + (lane >> 5); float v = W[(size_t)(k0 + kk) * N + n0s + (lane & 31)]; if (kscale) v *= kscale[k0 + kk]; scr[kk * 33 + (lane & 31)] = v; }
    LDS_WAIT(); asm volatile("" ::: "memory");
    const int c = lane & 7;
#pragma unroll
    for (int j = 0; j < 4; ++j) { const int n = (lane >> 3) + 8 * j; const LAS float* s = scr + (8 * c) * 33 + n;
        v4u o; o.x = pk2(s[0 * 33], s[1 * 33]); o.y = pk2(s[2 * 33], s[3 * 33]); o.z = pk2(s[4 * 33], s[5 * 33]); o.w = pk2(s[6 * 33], s[7 * 33]);
        *(GAS v4u*)(WT + (size_t)(n0d + n) * K + k0 + 8 * c) = o; }
    LDS_WAIT(); asm volatile("" ::: "memory");
}

struct Args { const float* in[15]; float* out; unsigned char* ws; };

__global__ void __launch_bounds__(NWAVES * 64, 2) skel_fwd(Args args) {
    extern __shared__ __attribute__((aligned(16))) unsigned char lds[];
    Frame F;
    F.lds = (LAS unsigned char*)lds;
    F.MISC = (volatile LAS unsigned*)(F.lds + MISC_OFF);
    F.tid = threadIdx.x; F.lane = F.tid & 63; F.wave = __builtin_amdgcn_readfirstlane(F.tid >> 6);
    F.G = gridDim.x; { const int bx = blockIdx.x; F.vcu = (F.G % 8 == 0) ? (bx % 8) * (F.G / 8) + bx / 8 : bx; }
    unsigned char* ws = args.ws;
    F.ctl = (gu32*)(ws + WS_CTL);
    const float* x = args.in[0]; const int* positions = (const int*)args.in[1]; const float* norm_mix_g = args.in[2]; const float* w_in = args.in[3];
    const float* gate_b = args.in[4]; const float* lambdas = args.in[5]; const float* subln_g = args.in[6]; const float* gm_norm_g = args.in[7];
    const float* gm_ws = args.in[8]; const float* gm_bs = args.in[9]; const float* w_out = args.in[10]; const float* norm_ffn_g = args.in[11];
    const float* w_ffn_in = args.in[12]; const float* w_ffn_out = args.in[13]; const float* norm_final_g = args.in[14];
    float* out = args.out;
    bf16* Win_t = (bf16*)(ws + WS_WIN); bf16* Wout_t = (bf16*)(ws + WS_WOUT); bf16* Wffi_t = (bf16*)(ws + WS_WFFI); bf16* Wffo_t = (bf16*)(ws + WS_WFFO);
    bf16* Wsp = (bf16*)(ws + WS_WSP); float* rope = (float*)(ws + WS_ROPE);
    float* gvss = (float*)(ws + WS_SS0); float* x1ss = (float*)(ws + WS_SS1); float* x2ss = (float*)(ws + WS_SS2);
    bf16* XN = (bf16*)(ws + WS_XN); bf16* GMB = (bf16*)(ws + WS_XN);
    bf16* QB_ = (bf16*)(ws + WS_Q); bf16* KB = (bf16*)(ws + WS_K); bf16* VB = (bf16*)(ws + WS_V); bf16* GU = (bf16*)(ws + WS_GU); bf16* GV = (bf16*)(ws + WS_GV);
    bf16* MERGED = (bf16*)(ws + WS_GU);
    bf16* G0 = (bf16*)out; bf16* G1 = (bf16*)out + (size_t)M * D;
    bf16* X1B = (bf16*)(ws + WS_Q);
    bf16* ACT = (bf16*)(ws + WS_K);

    for (int u = F.tid; u < (LDS_BYTES - LDSCTL_OFF) / 4; u += NWAVES * 64) ((LAS unsigned*)(F.lds + LDSCTL_OFF))[u] = 0u;
    __syncthreads();
    XcdBarrier bar = xcd_barrier_post((unsigned*)(F.ctl + CW_BAR), F.MISC + 8);
    const int gw = F.vcu * NWAVES + F.wave, NGW = F.G * NWAVES;

    {
        LAS float* scr = (LAS float*)(F.lds + RING_OFF + F.wave * 16384);
        constexpr int I_IN = (D / 64) * (DIN / 32), I_OUT = (D / 64) * (D / 32), I_FFI = (D / 64) * (2 * DFF / 32), I_FFO = (DFF / 64) * (D / 32);
        constexpr int NITEMS = I_IN + I_OUT + I_FFI + I_FFO;
        for (int it = gw; it < NITEMS; it += NGW) {
            int r = it;
            if (r < I_IN) { const int nblk = DIN / 32, kb = r / nblk, nb = r % nblk; p0_transpose_item(w_in, D, DIN, Win_t, 32 * nb, 32 * nb, 64 * kb, nullptr, scr, F.lane); continue; } r -= I_IN;
            if (r < I_OUT) { const int nblk = D / 32, kb = r / nblk, nb = r % nblk; p0_transpose_item(w_out, D, D, Wout_t, 32 * nb, 32 * nb, 64 * kb, nullptr, scr, F.lane); continue; } r -= I_OUT;
            if (r < I_FFI) { const int nblk = 2 * DFF / 32, kb = r / nblk, nb = r % nblk; const int n0d = 32 * nb, j = n0d >> 8, c = n0d & 255;
                const int n0s = (c < 128) ? 128 * j + c : DFF + 128 * j + (c - 128);
                p0_transpose_item(w_ffn_in, D, 2 * DFF, Wffi_t, n0d, n0s, 64 * kb, norm_ffn_g, scr, F.lane); continue; } r -= I_FFI;
            { const int nblk = D / 32, kb = r / nblk, nb = r % nblk; p0_transpose_item(w_ffn_out, DFF, D, Wffo_t, 32 * nb, 32 * nb, 64 * kb, nullptr, scr, F.lane); }
        }
        for (int e = (int)blockIdx.x * (NWAVES * 64) + F.tid; e < 8 * 128 * 128; e += F.G * NWAVES * 64) {
            const int jp = e & 127, i = (e >> 7) & 127, g = e >> 14; const int ks = jp >> 4, hh = (jp >> 3) & 1, jj = jp & 7; const int j = 16 * ks + 8 * (jj >> 2) + 4 * hh + (jj & 3);
            const float v = ((j >> 6) <= (i >> 6)) ? gm_ws[(size_t)(g * 128 + i) * 128 + j] : 0.f;
            Wsp[e] = (bf16)f2bf(v);
        }
        for (int e = (int)blockIdx.x * (NWAVES * 64) + F.tid; e < M * 8; e += F.G * NWAVES * 64) {
            const int m = e >> 3, i = e & 7;
            const float fr = (i == 0) ? 1.0f : (i == 1) ? 0.1939227432012558f : (i == 2) ? 0.03760603070259094f : (i == 3) ? 0.007292664609849453f : (i == 4) ? 0.0014142135623842478f
                           : (i == 5) ? 0.00027424818836152554f : (i == 6) ? 5.318296098266728e-05f : 1.0313386155758053e-05f;
            const float ang = (float)positions[m] * fr;
            const double tt = (double)ang * 0.15915494309189535; const float tf = (float)(tt - __builtin_rint(tt));
            rope[(size_t)m * 16 + i] = __builtin_amdgcn_cosf(tf); rope[(size_t)m * 16 + 8 + i] = __builtin_amdgcn_sinf(tf);
        }
        for (int m = gw; m < M; m += NGW) {
            const GAS f32x4* xr = (const GAS f32x4*)(x + (size_t)m * D) + F.lane; f32x4 v[4]; float s = 0.f;
#pragma unroll
            for (int j = 0; j < 4; ++j) { v[j] = xr[64 * j]; s += (v[j].x * v[j].x + v[j].y * v[j].y) + (v[j].z * v[j].z + v[j].w * v[j].w); }
            const float rinv = __builtin_amdgcn_rsqf(wave_sum(s) * (1.f / D) + 1e-6f);
            GAS unsigned long long* o8 = (GAS unsigned long long*)(XN + (size_t)m * D) + F.lane;
#pragma unroll
            for (int j = 0; j < 4; ++j) { const f32x4 gg = *((const f32x4*)norm_mix_g + F.lane + 64 * j);
                o8[64 * j] = (unsigned long long)pk2(v[j].x * rinv * gg.x, v[j].y * rinv * gg.y) | ((unsigned long long)pk2(v[j].z * rinv * gg.z, v[j].w * rinv * gg.w) << 32); }
        }
    }
    xcd_barrier(bar);

#if STOP_AFTER == 10
    { const size_t n = (size_t)M * D; for (size_t i = (size_t)blockIdx.x * 512 + F.tid; i < n; i += (size_t)F.G * 512)
        out[i] = pg8::bf2f(XN[i]) + pg8::bf2f(Win_t[i % ((size_t)DIN * D)]) + pg8::bf2f(Wffi_t[i % ((size_t)2 * DFF * D)]) + pg8::bf2f(Wffo_t[i % ((size_t)DFF * D)]) + pg8::bf2f(Wout_t[i % ((size_t)D * D)]) + rope[i % ((size_t)M * 16)] + pg8::bf2f(Wsp[i % 131072]); }
    return;
#endif
    {
        pg8::Gemm g{XN, Win_t, M, DIN, D}; pg8::StaticOrder S; S.init(M, DIN, F.G, (int)blockIdx.x);
        pg8::EpiProj E; E.dst5 = QB_; E.dstg = G0;
        E.rope = rope; E.gate_b = gate_b; E.gnorm = gm_norm_g; E.gvss = gvss; E.qscale = dattn::C2;
        pg8::gemm_phase<pg8::EpiProj, pg8::StaticOrder, true, true>(F.lds + RING_OFF, g, S, E);
    }
    xcd_barrier(bar);
#if STOP_AFTER == 1
    { const size_t n = (size_t)M * D; const unsigned* gp = (const unsigned*)out;
      for (size_t i = (size_t)blockIdx.x * 512 + F.tid; i < n; i += (size_t)F.G * 512) { const unsigned g2 = gp[i];
        out[i] = __uint_as_float(g2 << 16) + __uint_as_float(g2 & 0xffff0000u) + pg8::bf2f(QB_[i]) + pg8::bf2f(KB[i]) + pg8::bf2f(VB[i]) + pg8::bf2f(GU[i]) + pg8::bf2f(GV[i]) + gvss[i & ((size_t)M * 16 - 1)] * 0.001f; } }
    return;
#endif

    {
        const int per = (2048 + F.G - 1) / F.G;
        for (int i = 0; i < per; ++i) { const int id = F.vcu * per + i; if (id < 2048) dattn::gmlp_unit(id >> 7, (id >> 3) & 15, id & 7, GV, GU, G1, gvss, Wsp, gm_bs, GMB, F.lds + RING_OFF); }
    }
    xcd_barrier(bar);
#if STOP_AFTER == 2
    { const size_t n = (size_t)M * D; for (size_t i = (size_t)blockIdx.x * 512 + F.tid; i < n; i += (size_t)F.G * 512) out[i] = pg8::bf2f(GMB[i]); }
    return;
#endif

    {
        const float a = lambdas[F.lane] * lambdas[64 + F.lane], c = lambdas[128 + F.lane] * lambdas[192 + F.lane];
        const float lam = __expf(wave_sum(a)) - __expf(wave_sum(c)) + 0.2f;
        const int per = (1024 + F.G - 1) / F.G;
        for (int j = 0; j < per; ++j) { const int pr = F.vcu * per + j; if (pr >= 1024) break; const int bh = pr >> 3, s = pr & 7;
            for (int k = 0; k < 2; ++k) dattn::unit(bh >> 3, bh & 7, k ? 15 - s : s, QB_, KB, VB, G0, GMB, MERGED, subln_g, lam, F.lds + RING_OFF, (LAS float*)(F.lds + WSF_OFF)); }
    }
    xcd_barrier(bar);
#if STOP_AFTER == 3
    { const size_t n = (size_t)M * D; for (size_t i = (size_t)blockIdx.x * 512 + F.tid; i < n; i += (size_t)F.G * 512) out[i] = pg8::bf2f(MERGED[i]); }
    return;
#endif

    {
        pg8::Gemm g{MERGED, Wout_t, M, D, D}; pg8::StaticOrder S; S.init(M, D, F.G, (int)blockIdx.x);
        pg8::EpiResid E{x, out, X1B, x1ss};
        pg8::gemm_phase<pg8::EpiResid, pg8::StaticOrder, true, true>(F.lds + RING_OFF, g, S, E);
    }
    xcd_barrier(bar);
#if STOP_AFTER == 4
    return;
#endif

    {
        pg8::Gemm g{X1B, Wffi_t, M, 2 * DFF, D}; pg8::StaticOrder S; S.init(M, 2 * DFF, F.G, (int)blockIdx.x);
        pg8::EpiSwiglu E{ACT, x1ss, DFF};
        pg8::gemm_phase<pg8::EpiSwiglu, pg8::StaticOrder, true, true>(F.lds + RING_OFF, g, S, E);
    }
    xcd_barrier(bar);
#if STOP_AFTER == 5
    { const size_t n = (size_t)M * D; for (size_t i = (size_t)blockIdx.x * 512 + F.tid; i < n; i += (size_t)F.G * 512) out[i] = pg8::bf2f(ACT[i]) + pg8::bf2f(ACT[i + n]); }
    return;
#endif

    {
        pg8::Gemm g{ACT, Wffo_t, M, D, DFF}; pg8::StaticOrder S; S.init(M, D, F.G, (int)blockIdx.x);
        pg8::EpiResid E{out, out, nullptr, x2ss};
        pg8::gemm_phase<pg8::EpiResid, pg8::StaticOrder, true, true>(F.lds + RING_OFF, g, S, E);
    }
    xcd_barrier(bar);

    {
        const unsigned poison = xb_ld((unsigned*)(F.ctl + CW_BAR) + XB_TMO);
        for (int m = gw; m < M; m += NGW) {
            GAS f32x4* xr = (GAS f32x4*)(out + (size_t)m * D) + F.lane; f32x4 v[4];
#pragma unroll
            for (int j = 0; j < 4; ++j) v[j] = xr[64 * j];
            float s = x2ss[(size_t)m * 16 + (F.lane & 15)];
            s += __shfl_xor(s, 1); s += __shfl_xor(s, 2); s += __shfl_xor(s, 4); s += __shfl_xor(s, 8);
            float rinv = __builtin_amdgcn_rsqf(s * (1.f / D) + 1e-6f);
            if (poison) rinv = __builtin_nanf("");
#pragma unroll
            for (int j = 0; j < 4; ++j) { const f32x4 gg = *((const f32x4*)norm_final_g + F.lane + 64 * j); xr[64 * j] = v[j] * rinv * gg; }
        }
    }
}

extern "C" void kernel_launch(void* const* d_in, const int* in_sizes, int n_in, void* d_out, int out_size, void* d_ws, size_t ws_size, hipStream_t stream) {
    static int grid = 0;
    if (grid == 0) {
        if (n_in != 15 || in_sizes[0] != M * D || out_size != M * D || ws_size < WS_END) { fprintf(stderr, "kernel_launch: unexpected shapes (n_in %d, in0 %d, out %d, ws %zu < %zu); nothing launched\n", n_in, n_in > 0 ? in_sizes[0] : -1, out_size, ws_size, (size_t)WS_END); grid = -1; return; }
        int dev = 0, cus = 0;
        if (hipGetDevice(&dev) != hipSuccess || hipDeviceGetAttribute(&cus, hipDeviceAttributeMultiprocessorCount, dev) != hipSuccess) { fprintf(stderr, "kernel_launch: device query failed\n"); grid = -1; return; }
        if (hipFuncSetAttribute((const void*)skel_fwd, hipFuncAttributeMaxDynamicSharedMemorySize, LDS_BYTES) != hipSuccess) { fprintf(stderr, "kernel_launch: hipFuncSetAttribute failed\n"); grid = -1; return; }
        int per_cu = 0;
        if (hipOccupancyMaxActiveBlocksPerMultiprocessor(&per_cu, (const void*)skel_fwd, NWAVES * 64, LDS_BYTES) != hipSuccess || per_cu < 1) fprintf(stderr, "kernel_launch: note: occupancy query reports %d\n", per_cu);
        (void)hipGetLastError();
        grid = cus;
        if (grid != 256) fprintf(stderr, "kernel_launch: %d CUs; the unit dealing assumes 256\n", grid);
    }
    if (grid < 0) return;
    if (hipMemsetAsync((char*)d_ws + WS_CTL, 0, CTL_ZERO_BYTES, stream) != hipSuccess) { fprintf(stderr, "kernel_launch: hipMemsetAsync failed\n"); return; }
    Args a{};
    for (int i = 0; i < 15; ++i) a.in[i] = (const float*)d_in[i];
    a.out = (float*)d_out; a.ws = (unsigned char*)d_ws;
    hipLaunchKernelGGL(skel_fwd, dim3(grid), dim3(NWAVES * 64), LDS_BYTES, stream, a);
    const hipError_t le = hipPeekAtLastError();
    if (le != hipSuccess) fprintf(stderr, "kernel_launch: launch failed: %s\n", hipGetErrorName(le));
}
```

```cpp
#include <hip/hip_runtime.h>
#include <cstdio>
#include <cstdint>
#ifndef EPI_PLAIN
#define EPI_PLAIN 0
#endif
namespace pg8 {
#define PG8_LAS __attribute__((address_space(3)))
typedef unsigned short bf16_t;
typedef short bf16x8 __attribute__((ext_vector_type(8)));
typedef float f32x4 __attribute__((ext_vector_type(4)));
typedef unsigned u32x4 __attribute__((ext_vector_type(4)));
constexpr int BM = 256, BK = 64, HALF = 128, HTB = HALF * BK * 2  , STAGE_BYTES = 8 * HTB, NXCD = 8, WGM = 8;

__host__ __device__ __forceinline__ int lds_byte(int r, int c) { const int st = (r >> 4) * 2 + (c >> 5), rr = r & 15, cc = c & 31, ob = rr * 64 + cc * 2; return st * 1024 + (ob ^ (((ob >> 9) & 1) << 5)); }
__host__ __device__ __forceinline__ void stage_rc(int b, int& R, int& C) { const int st = b / 1024, sb = b % 1024, swz = sb ^ (((sb >> 9) & 1) << 5); R = (st >> 1) * 16 + swz / 64; C = (st & 1) * 32 + (swz % 64) / 2; }
__host__ __device__ __forceinline__ int perm32(int rho) { const int n = rho >> 4, i = rho & 15; return 8 * (i >> 2) + 4 * n + (i & 3); }

struct Unit { int pm, pn; };
struct Gemm { const bf16_t* A; const bf16_t* Bt; int M, N, K; };

struct StaticOrder {
    int nM, nN, nwg, G, c;
    __host__ __device__ void init(int M, int N, int G_, int c_) { nM = M / BM; nN = N / BM; nwg = nM * nN; G = G_; c = c_; }
    __host__ __device__ bool next(int i, Unit& u) const {
        const long L = (long)i * G + c; if (L >= nwg) return false;
        int wgid = (int)L; { const int q = nwg / NXCD, r = nwg % NXCD, xcd = wgid % NXCD, off = wgid / NXCD; wgid = (xcd < r ? xcd * (q + 1) : r * (q + 1) + (xcd - r) * q) + off; }
        const int nig = WGM * nN, gid = wgid / nig, fm = gid * WGM, gsz = (nM - fm) < WGM ? (nM - fm) : WGM;
        u.pm = fm + ((wgid % nig) % gsz); u.pn = (wgid % nig) / gsz; return true;
    }
    __device__ __forceinline__ void a_ready(const Unit&) const {}
    __device__ __forceinline__ void done(const Unit&) const {}
};

typedef float f32x2c_t __attribute__((ext_vector_type(2))); typedef __bf16 bf16x2c_t __attribute__((ext_vector_type(2)));
__device__ __forceinline__ unsigned cvt_pk_bf16(float lo, float hi) { f32x2c_t v = {lo, hi}; bf16x2c_t b = __builtin_convertvector(v, bf16x2c_t); return __builtin_bit_cast(unsigned, b); }
typedef float f32x2 __attribute__((ext_vector_type(2)));
__device__ __forceinline__ f32x2 gelu_pk(f32x2 v) {
    const f32x2 av = __builtin_elementwise_abs(v), d = av * 0.2316418882f + 1.0f;
    f32x2 t; t.x = __builtin_amdgcn_rcpf(d.x); t.y = __builtin_amdgcn_rcpf(d.y);
    f32x2 q = t * 0.5307027145f + (-0.7265760135f); q = q * t + 0.7107068705f; q = q * t + (-0.142248368f); q = q * t + 0.127414796f; q = q * t;
    const f32x2 s = (v * v) * (-0.72134752044f);
    f32x2 e; e.x = __builtin_amdgcn_exp2f(s.x); e.y = __builtin_amdgcn_exp2f(s.y);
    const f32x2 m = v * (q * e), r = v - m;
    f32x2 o; o.x = v.x < 0.f ? m.x : r.x; o.y = v.y < 0.f ? m.y : r.y; return o;
}

__device__ __forceinline__ float bf2f(unsigned short h) { return __uint_as_float((unsigned)h << 16); }
__device__ __forceinline__ float sigm(float x) { return __builtin_amdgcn_rcpf(1.0f + __builtin_amdgcn_exp2f(-1.4426950408889634f * x)); }
__device__ __forceinline__ f32x4 gelu4(f32x4 v) { const f32x2 a = gelu_pk((f32x2){v[0], v[1]}), b = gelu_pk((f32x2){v[2], v[3]}); return (f32x4){a.x, a.y, b.x, b.y}; }
__device__ __forceinline__ float dot4(f32x4 v) { return (v[0] * v[0] + v[1] * v[1]) + (v[2] * v[2] + v[3] * v[3]); }

struct EpiProj {
    static constexpr bool PERM = true, AFTER_DRAIN = false;
    bf16_t* dst5; bf16_t* dstg; const float* rope; const float* gate_b; const float* gnorm; float* gvss; float qscale;
    template <int KIND> __device__ __forceinline__ void body(const f32x4 (&acc)[2][2][4][2], const Unit& u, int seg, int wr, int wc, int fr, int fq) const {
        const int colt = (u.pn & 3) * BM;
        const int row0 = u.pm * BM + wr * 64 + fr, col0 = colt + wc * 32 + 8 * fq;
        bf16_t* base = (seg < 5) ? dst5 + (size_t)seg * ((size_t)32768 * 1024) : dstg + (size_t)(seg - 5) * ((size_t)32768 * 1024);
        const float sc = (seg == 0) ? qscale : 1.f;
        const bool rotw = (KIND == 0) && ((wc & 1) == 0);
        f32x4 cv[2][2];
        if (KIND == 3 || KIND == 4) { const float* p = (KIND == 3) ? gnorm : gate_b + (seg - 5) * 1024;
#pragma unroll
            for (int bj = 0; bj < 2; ++bj)
#pragma unroll
                for (int n = 0; n < 2; ++n) cv[bj][n] = *(const f32x4*)(p + col0 + bj * HALF + 4 * n); }
#pragma unroll
        for (int ai = 0; ai < 2; ++ai)
#pragma unroll
            for (int m = 0; m < 4; ++m) {
                const int row = row0 + ai * HALF + m * 16;
                f32x4 cs0, cs1, sn0, sn1;
                if (KIND == 0) { if (rotw) { const f32x4* rp = (const f32x4*)(rope + (size_t)row * 16); const f32x4 c0 = rp[0], c1 = rp[1], s0 = rp[2], s1 = rp[3];
                    const float sg = (fq == 0) ? -1.f : ((fq == 1) ? 1.f : 0.f); const bool rl = fq < 2;
                    cs0 = rl ? c0 : (f32x4){1.f, 1.f, 1.f, 1.f}; cs1 = rl ? c1 : (f32x4){1.f, 1.f, 1.f, 1.f}; sn0 = s0 * sg; sn1 = s1 * sg; } }
                float ss = 0.f;
                bf16_t* rowp = base + (size_t)row * 1024 + col0;
#pragma unroll
                for (int bj = 0; bj < 2; ++bj) {
                    f32x4 v0 = acc[ai][bj][m][0], v1 = acc[ai][bj][m][1];
                    if (KIND == 0) {
                        if (rotw) { f32x4 p0, p1;
#pragma unroll
                            for (int i = 0; i < 4; ++i) { p0[i] = __shfl_xor(v0[i], 16); p1[i] = __shfl_xor(v1[i], 16); }
                            v0 = v0 * cs0 + p0 * sn0; v1 = v1 * cs1 + p1 * sn1; }
                        v0 = v0 * sc; v1 = v1 * sc;
                    }
                    if (KIND == 2 || KIND == 3) { v0 = gelu4(v0); v1 = gelu4(v1); }
                    if (KIND == 3) { ss += dot4(v0) + dot4(v1); v0 = v0 * cv[bj][0]; v1 = v1 * cv[bj][1]; }
                    if (KIND == 4) { v0 = v0 + cv[bj][0]; v1 = v1 + cv[bj][1];
#pragma unroll
                        for (int i = 0; i < 4; ++i) { v0[i] = sigm(v0[i]); v1[i] = sigm(v1[i]); } }
                    u32x4 w; w.x = cvt_pk_bf16(v0[0], v0[1]); w.y = cvt_pk_bf16(v0[2], v0[3]); w.z = cvt_pk_bf16(v1[0], v1[1]); w.w = cvt_pk_bf16(v1[2], v1[3]);
                    *(u32x4*)(rowp + bj * HALF) = w;
                }
                if (KIND == 3) { ss += __shfl_xor(ss, 16); ss += __shfl_xor(ss, 32); if (fq == 0) __hip_atomic_store(gvss + (size_t)row * 16 + (u.pn & 3) * 4 + wc, ss, __ATOMIC_RELAXED, __HIP_MEMORY_SCOPE_AGENT); }
            }
    }
    __device__ __forceinline__ void operator()(const f32x4 (&acc)[2][2][4][2], const Unit& u, int wr, int wc, int fr, int fq) const {
        const int seg = u.pn >> 2;
#if EPI_PLAIN
        body<1>(acc, u, seg, wr, wc, fr, fq); return;
#endif
        if (seg <= 1) body<0>(acc, u, seg, wr, wc, fr, fq);
        else if (seg == 2) body<1>(acc, u, seg, wr, wc, fr, fq);
        else if (seg == 3) body<2>(acc, u, seg, wr, wc, fr, fq);
        else if (seg == 4) body<3>(acc, u, seg, wr, wc, fr, fq);
        else body<4>(acc, u, seg, wr, wc, fr, fq);
    }
};

struct EpiResid {
    static constexpr bool PERM = false, AFTER_DRAIN = false;
    const float* base; float* out; bf16_t* xb; float* ss;
    __device__ __forceinline__ void operator()(const f32x4 (&acc)[2][2][4][2], const Unit& u, int wr, int wc, int fr, int fq) const {
        typedef unsigned u32x2v __attribute__((ext_vector_type(2)));
        const int row0 = u.pm * BM + wr * 64 + fr, col0 = u.pn * BM + wc * 32 + 4 * fq;
#pragma unroll
        for (int ai = 0; ai < 2; ++ai)
#pragma unroll
            for (int m = 0; m < 4; ++m) {
                const int row = row0 + ai * HALF + m * 16; const size_t off = (size_t)row * 1024 + col0; float s = 0.f;
#pragma unroll
                for (int bj = 0; bj < 2; ++bj)
#pragma unroll
                    for (int n = 0; n < 2; ++n) {
                        const f32x4 bs = *(const f32x4*)(base + off + bj * HALF + n * 16); const f32x4 o = bs + acc[ai][bj][m][n];
                        *(f32x4*)(out + off + bj * HALF + n * 16) = o; s += dot4(o);
                        if (xb) { u32x2v w; w.x = cvt_pk_bf16(o[0], o[1]); w.y = cvt_pk_bf16(o[2], o[3]); *(u32x2v*)(xb + off + bj * HALF + n * 16) = w; }
                    }
                s += __shfl_xor(s, 16); s += __shfl_xor(s, 32);
                if (fq == 0) __hip_atomic_store(ss + (size_t)row * 16 + u.pn * 4 + wc, s, __ATOMIC_RELAXED, __HIP_MEMORY_SCOPE_AGENT);
                if (m & 1) asm volatile("" ::: "memory");
            }
    }
};

struct EpiSwiglu {
    static constexpr bool PERM = true, AFTER_DRAIN = false;
    bf16_t* act; const float* ss; int ldc;
    __device__ __forceinline__ void operator()(const f32x4 (&acc)[2][2][4][2], const Unit& u, int wr, int wc, int fr, int fq) const {
        const int row0 = u.pm * BM + wr * 64 + fr, col0 = u.pn * HALF + wc * 32 + 8 * fq;
#pragma unroll
        for (int ai = 0; ai < 2; ++ai)
#pragma unroll
            for (int m = 0; m < 4; ++m) {
                const int row = row0 + ai * HALF + m * 16;
                const f32x4* sp = (const f32x4*)(ss + (size_t)row * 16); const f32x4 t = (sp[0] + sp[1]) + (sp[2] + sp[3]);
                const float rinv = __builtin_amdgcn_rsqf(((t[0] + t[1]) + (t[2] + t[3])) * (1.0f / 1024.0f) + 1e-6f);
                f32x4 h[2];
#pragma unroll
                for (int n = 0; n < 2; ++n) { const f32x4 a = acc[ai][0][m][n] * rinv, b = acc[ai][1][m][n] * rinv;
#pragma unroll
                    for (int i = 0; i < 4; ++i) h[n][i] = a[i] * sigm(a[i]) * b[i]; }
                u32x4 w; w.x = cvt_pk_bf16(h[0][0], h[0][1]); w.y = cvt_pk_bf16(h[0][2], h[0][3]); w.z = cvt_pk_bf16(h[1][0], h[1][1]); w.w = cvt_pk_bf16(h[1][2], h[1][3]);
                *(u32x4*)(act + (size_t)row * ldc + col0) = w;
            }
    }
};

template <class Epi, class Sched, bool ALIGN_EPI = false, bool SP2 = false>
__device__ __forceinline__ void gemm_phase(PG8_LAS unsigned char* lds, const Gemm g, const Sched& S, const Epi& E) {
    const int tid = threadIdx.x, wid = __builtin_amdgcn_readfirstlane(tid >> 6), lane = tid & 63, wr = wid >> 2, wc = wid & 3, fr = lane & 15, fq = lane >> 4;
    const int K = g.K, nt = K / BK;
    unsigned voffA[2], voffB[2];
#pragma unroll
    for (int i = 0; i < 2; ++i) { int R, C; stage_rc(tid * 16 + i * 8192, R, C); const int Rb = Epi::PERM ? ((R & ~31) + perm32(R & 31)) : R;
        voffA[i] = (unsigned)(R * K + C) * 2u; voffB[i] = (unsigned)(Rb * K + C) * 2u; }
    const size_t kstep = (size_t)(BK * 2);
    const size_t hstep = (size_t)HALF * K * 2;
    const size_t tstep = 2 * hstep;
    const unsigned ldsw = (unsigned)wid * 1024u;
    const int aoff = lds_byte(wr * 64 + fr, fq * 8), boff = lds_byte(wc * 32 + fr, fq * 8);
#define PG8_SA(b, h) (((b) * 2 + (h)) * HTB)
#define PG8_SB(b, h) ((4 + (b) * 2 + (h)) * HTB)
#define PG8_STAGE(bufoff, gbase, voff) do { _Pragma("unroll") for (int _i = 0; _i < 2; ++_i) \
        __builtin_amdgcn_global_load_lds((const unsigned*)((const char*)(gbase) + (voff)[_i]), (PG8_LAS unsigned*)(lds + (bufoff) + ldsw + _i * 8192), 16, 0, 0); } while (0)
#define PG8_LDA(dst, b, h) do { _Pragma("unroll") for (int m = 0; m < 4; ++m) _Pragma("unroll") for (int k = 0; k < 2; ++k) dst[m][k] = *(const PG8_LAS bf16x8*)(lds + PG8_SA(b, h) + aoff + m * 2048 + k * 1024); } while (0)
#define PG8_LDB(dst, b, h) do { _Pragma("unroll") for (int n = 0; n < 2; ++n) _Pragma("unroll") for (int k = 0; k < 2; ++k) dst[n][k] = *(const PG8_LAS bf16x8*)(lds + PG8_SB(b, h) + boff + n * 2048 + k * 1024); } while (0)
#define PG8_MMA(ai, bj, At, Bt) do { __builtin_amdgcn_s_setprio(1); _Pragma("unroll") for (int m = 0; m < 4; ++m) _Pragma("unroll") for (int n = 0; n < 2; ++n) _Pragma("unroll") for (int k = 0; k < 2; ++k) \
        acc[ai][bj][m][n] = __builtin_amdgcn_mfma_f32_16x16x32_bf16(Bt[n][k], At[m][k], acc[ai][bj][m][n], 0, 0, 0); __builtin_amdgcn_s_setprio(0); } while (0)
#define PG8_WAIT_V(n) asm volatile("s_waitcnt vmcnt(" #n ")" ::: "memory")
#define PG8_WAIT_L(n) asm volatile("s_waitcnt lgkmcnt(" #n ")" ::: "memory")
#define PG8_BAR __builtin_amdgcn_s_barrier()
#define PG8_SCHED __builtin_amdgcn_sched_barrier(0)
    Unit cur, nxt; int ui = 0;
    if (!S.next(0, cur)) return;
    f32x4 acc[2][2][4][2];
#pragma unroll
    for (int a = 0; a < 2; ++a)
#pragma unroll
        for (int b = 0; b < 2; ++b)
#pragma unroll
            for (int m = 0; m < 4; ++m)
#pragma unroll
                for (int n = 0; n < 2; ++n) acc[a][b][m][n] = (f32x4){0.f, 0.f, 0.f, 0.f};
    bf16x8 At[4][2], B0[2][2], B1[2][2];
    const char* cA = (const char*)g.A + (size_t)cur.pm * tstep; const char* cB = (const char*)g.Bt + (size_t)cur.pn * tstep;
    S.a_ready(cur);
    if constexpr (SP2) {
        PG8_STAGE(PG8_SB(0, 0), cB, voffB); PG8_STAGE(PG8_SB(0, 1), cB + hstep, voffB); PG8_STAGE(PG8_SA(0, 0), cA, voffA); PG8_STAGE(PG8_SA(0, 1), cA + hstep, voffA);
        if (wr == 1) PG8_BAR;
        PG8_WAIT_V(2); PG8_BAR;
        PG8_STAGE(PG8_SB(1, 0), cB + kstep, voffB); PG8_STAGE(PG8_SA(1, 0), cA + kstep, voffA); PG8_STAGE(PG8_SB(1, 1), cB + hstep + kstep, voffB);
        PG8_WAIT_V(6); PG8_BAR;
    } else {
        PG8_STAGE(PG8_SB(0, 0), cB, voffB); PG8_STAGE(PG8_SA(0, 0), cA, voffA); PG8_STAGE(PG8_SB(0, 1), cB + hstep, voffB); PG8_STAGE(PG8_SA(0, 1), cA + hstep, voffA);
        if (wr == 1) PG8_BAR;
        PG8_WAIT_V(4); PG8_BAR;
        PG8_STAGE(PG8_SB(1, 0), cB + kstep, voffB); PG8_STAGE(PG8_SA(1, 0), cA + kstep, voffA); PG8_STAGE(PG8_SB(1, 1), cB + hstep + kstep, voffB);
        PG8_WAIT_V(6); PG8_BAR;
    }
    for (;;) {
        const bool has_next = S.next(ui + 1, nxt);
        const char* nA = has_next ? (const char*)g.A + (size_t)nxt.pm * tstep : cA; const char* nB = has_next ? (const char*)g.Bt + (size_t)nxt.pn * tstep : cB;
        for (int t = 0; t < nt; t += 2) {
            const bool last = (t == nt - 2);
            const char* a1 = cA + (size_t)(t + 1) * kstep;
            const char* a2 = last ? nA : cA + (size_t)(t + 2) * kstep; const char* b2 = last ? nB : cB + (size_t)(t + 2) * kstep;
            const char* a3 = a2 + kstep; const char* b3 = b2 + kstep;
            if (last && has_next) S.a_ready(nxt);
            if constexpr (SP2) {
            PG8_LDB(B0, 0, 0); PG8_LDB(B1, 0, 1); PG8_SCHED; PG8_LDA(At, 0, 0); PG8_STAGE(PG8_SA(1, 1), a1 + hstep, voffA);
            PG8_WAIT_V(8); PG8_WAIT_L(0); PG8_BAR; PG8_MMA(0, 0, At, B0); PG8_MMA(0, 1, At, B1); PG8_BAR; PG8_SCHED;
            PG8_LDA(At, 0, 1); PG8_STAGE(PG8_SB(0, 0), b2, voffB); PG8_STAGE(PG8_SB(0, 1), b2 + hstep, voffB); PG8_STAGE(PG8_SA(0, 0), a2, voffA);
            PG8_WAIT_V(8); PG8_WAIT_L(0); PG8_BAR; PG8_MMA(1, 0, At, B0); PG8_MMA(1, 1, At, B1); PG8_BAR; PG8_SCHED;
            PG8_LDB(B0, 1, 0); PG8_LDB(B1, 1, 1); PG8_SCHED; PG8_LDA(At, 1, 0); PG8_STAGE(PG8_SA(0, 1), a2 + hstep, voffA);
            PG8_WAIT_V(8); PG8_WAIT_L(0); PG8_BAR; PG8_MMA(0, 0, At, B0); PG8_MMA(0, 1, At, B1); PG8_BAR; PG8_SCHED;
            PG8_LDA(At, 1, 1); PG8_STAGE(PG8_SB(1, 0), b3, voffB); PG8_STAGE(PG8_SB(1, 1), b3 + hstep, voffB); PG8_STAGE(PG8_SA(1, 0), a3, voffA);
            PG8_WAIT_V(8); PG8_WAIT_L(0); PG8_BAR; PG8_MMA(1, 0, At, B0); PG8_MMA(1, 1, At, B1); PG8_BAR; PG8_SCHED;
            } else {
            PG8_LDB(B0, 0, 0); PG8_SCHED; PG8_LDA(At, 0, 0); PG8_STAGE(PG8_SA(1, 1), a1 + hstep, voffA);
            PG8_WAIT_L(8); PG8_BAR; PG8_WAIT_L(0); PG8_MMA(0, 0, At, B0); PG8_BAR; PG8_SCHED;
            PG8_LDB(B1, 0, 1); PG8_STAGE(PG8_SB(0, 0), b2, voffB);
            PG8_BAR; PG8_WAIT_L(0); PG8_MMA(0, 1, At, B1); PG8_BAR;
            PG8_LDA(At, 0, 1); PG8_STAGE(PG8_SA(0, 0), a2, voffA);
            PG8_BAR; PG8_WAIT_L(0); PG8_MMA(1, 0, At, B0); PG8_BAR; PG8_SCHED;
            PG8_STAGE(PG8_SB(0, 1), b2 + hstep, voffB);
            PG8_WAIT_V(6); PG8_BAR; PG8_MMA(1, 1, At, B1); PG8_BAR;
            PG8_LDB(B0, 1, 0); PG8_SCHED; PG8_LDA(At, 1, 0); PG8_STAGE(PG8_SA(0, 1), a2 + hstep, voffA);
            PG8_WAIT_L(8); PG8_BAR; PG8_WAIT_L(0); PG8_MMA(0, 0, At, B0); PG8_BAR; PG8_SCHED;
            PG8_LDB(B1, 1, 1); PG8_STAGE(PG8_SB(1, 0), b3, voffB);
            PG8_BAR; PG8_WAIT_L(0); PG8_MMA(0, 1, At, B1); PG8_BAR;
            PG8_LDA(At, 1, 1); PG8_STAGE(PG8_SA(1, 0), a3, voffA);
            PG8_BAR; PG8_WAIT_L(0); PG8_MMA(1, 0, At, B0); PG8_BAR; PG8_SCHED;
            PG8_STAGE(PG8_SB(1, 1), b3 + hstep, voffB);
            PG8_WAIT_V(6); PG8_BAR; PG8_MMA(1, 1, At, B1); PG8_BAR;
            }
        }
        if constexpr (ALIGN_EPI) { if (wr == 0) PG8_BAR; }
        if constexpr (!Epi::AFTER_DRAIN) { E(acc, cur, wr, wc, fr, fq); S.done(cur); }
        if (!has_next) break;
#pragma unroll
        for (int a = 0; a < 2; ++a)
#pragma unroll
            for (int b = 0; b < 2; ++b)
#pragma unroll
                for (int m = 0; m < 4; ++m)
#pragma unroll
                    for (int n = 0; n < 2; ++n) acc[a][b][m][n] = (f32x4){0.f, 0.f, 0.f, 0.f};
        cur = nxt; cA = nA; cB = nB; ++ui;
        if constexpr (ALIGN_EPI) { if (wr == 1) PG8_BAR; }
    }
    PG8_WAIT_V(0);
    if constexpr (!ALIGN_EPI) { if (wr == 0) PG8_BAR; }
    PG8_BAR;
    if constexpr (Epi::AFTER_DRAIN) { E.fused(acc, cur, wr, wc, fr, fq, lds, wid, lane); S.done(cur); }
#undef PG8_SA
#undef PG8_SB
#undef PG8_STAGE
#undef PG8_LDA
#undef PG8_LDB
#undef PG8_MMA
#undef PG8_WAIT_V
#undef PG8_WAIT_L
#undef PG8_BAR
#undef PG8_SCHED
}
}
namespace dattn {
#define DLAS __attribute__((address_space(3)))
typedef unsigned short bf16_t;
using bf16x8 = __attribute__((ext_vector_type(8))) short;
using s16x4 = __attribute__((ext_vector_type(4))) short;
using f32x16 = __attribute__((ext_vector_type(16))) float;
using f32x4 = __attribute__((ext_vector_type(4))) float;
using u32x4 = __attribute__((ext_vector_type(4))) unsigned;
typedef short v4i16_t __attribute__((ext_vector_type(4)));
constexpr int SEQ = 2048, DM = 1024, QB = 128, KVBLK = 64;
constexpr int SLOTB = 32768, OFF_K1 = 0, OFF_K2 = 8192, OFF_V = 16384;
constexpr float C2 = 0.125f * 1.4426950408889634f;
constexpr float THR = 8.0f;
__device__ __forceinline__ int crow(int r, int hi) { return (r & 3) + 8 * (r >> 2) + 4 * hi; }
__device__ __forceinline__ void glds16(const void* gsrc, unsigned lds_dst) { unsigned keep;
    asm volatile("s_mov_b32 %0, m0\n\ts_mov_b32 m0, %2\n\ts_nop 0\n\tglobal_load_lds_dwordx4 %1, off\n\ts_mov_b32 m0, %0" : "=&s"(keep) : "v"(gsrc), "s"(lds_dst) : "memory"); }
__device__ __forceinline__ s16x4 vtr(const DLAS unsigned char* p) { return __builtin_bit_cast(s16x4, __builtin_amdgcn_ds_read_tr16_b64_v4i16((DLAS v4i16_t*)p)); }
__device__ __forceinline__ float bf2f(unsigned short h) { return __uint_as_float((unsigned)h << 16); }
typedef float f32x2_t __attribute__((ext_vector_type(2))); typedef __bf16 bf16x2_t __attribute__((ext_vector_type(2)));
__device__ __forceinline__ unsigned cvtpk(float lo, float hi) { f32x2_t v = {lo, hi}; bf16x2_t b = __builtin_convertvector(v, bf16x2_t); return __builtin_bit_cast(unsigned, b); }
#define MX3(a, b, c) __builtin_fmaxf(__builtin_fmaxf((a), (b)), (c))
__device__ __forceinline__ float rowmax(const f32x16& p0, const f32x16& p1) {
    float a = MX3(p0[0], p0[1], p1[0]), b = MX3(p0[2], p0[3], p1[1]); a = MX3(a, p1[2], p1[3]);
#pragma unroll
    for (int r = 4; r < 16; r += 4) { a = MX3(a, p0[r], p0[r + 1]); b = MX3(b, p0[r + 2], p0[r + 3]); a = MX3(a, p1[r], p1[r + 1]); b = MX3(b, p1[r + 2], p1[r + 3]); }
    float m = __builtin_fmaxf(a, b); auto rr = __builtin_amdgcn_permlane32_swap(__float_as_uint(m), __float_as_uint(m), false, false);
    return __builtin_fmaxf(__uint_as_float(rr[0]), __uint_as_float(rr[1])); }
#define MFMA32(a, b, c) __builtin_amdgcn_mfma_f32_32x32x16_bf16(a, b, c, 0, 0, 0)
#define WAIT_BAR(N) asm volatile("s_waitcnt vmcnt(" #N ") lgkmcnt(0)\n\ts_barrier" ::: "memory")
#define BAR_ALL() asm volatile("s_waitcnt vmcnt(0) lgkmcnt(0)\n\ts_barrier" ::: "memory")

__device__ __forceinline__ void unit(int b, int h, int qb, const bf16_t* Q, const bf16_t* K, const bf16_t* V, const bf16_t* G0, const bf16_t* GM, bf16_t* MERGED,
                                     const float* subln_g, float lam, DLAS unsigned char* shm, DLAS float* wsf_base) {
    const int tid = threadIdx.x, lane = tid & 63, r32 = lane & 31, hi = lane >> 5; const int wid = __builtin_amdgcn_readfirstlane(tid >> 6);
    const int map = wid >> 2, rq = wid & 3;
    const long rowbase = (long)b * SEQ; const int q0 = qb * QB;
    const int NT = 2 * qb + 2, myNT = (rq < 2) ? NT - 1 : NT;
    const bf16_t* Qw = Q + (rowbase + q0 + rq * 32) * DM + h * 128 + map * 64;
    const bf16_t* Kh = K + rowbase * DM + h * 128; const bf16_t* Vh = V + rowbase * DM + h * 128;
    const unsigned lds0 = (unsigned)(uintptr_t)shm;
    DLAS float* wsf = wsf_base + wid * 64;
    const bf16_t* ksrc1 = Kh + (long)lane * DM + wid * 8; const bf16_t* ksrc2 = ksrc1 + 64;
    const bf16_t* vsrcA = Vh + (long)(16 * (wid & 3) + (lane >> 2)) * DM + (wid >> 2) * 32 + (lane & 3) * 8; const bf16_t* vsrcB = vsrcA + 64;
    const unsigned dK1 = lds0 + OFF_K1 + wid * 1024, dK2 = lds0 + OFF_K2 + wid * 1024, dVA = lds0 + OFF_V + wid * 1024, dVB = lds0 + OFF_V + (wid + 8) * 1024;
#define RFL(x) ((unsigned)__builtin_amdgcn_readfirstlane(x))
#define DMA_T(t, slot) do { const long go_ = (long)(t) * KVBLK * DM; glds16(ksrc1 + go_, RFL(dK1 + (slot))); glds16(ksrc2 + go_, RFL(dK2 + (slot))); glds16(vsrcA + go_, RFL(dVA + (slot))); glds16(vsrcB + go_, RFL(dVB + (slot))); } while (0)
    const DLAS unsigned char* kp0 = shm + (map ? OFF_K2 : OFF_K1) + hi * 1024 + r32 * 16;
    const DLAS unsigned char* vp0 = shm + OFF_V + ((lane >> 4) & 1) * 32 + (lane & 3) * 8 + (4 * hi + ((lane & 15) >> 2)) * 64;
    bf16x8 qr[4];
#pragma unroll
    for (int d0 = 0; d0 < 4; ++d0) qr[d0] = *reinterpret_cast<const bf16x8*>(Qw + (long)r32 * DM + d0 * 16 + hi * 8);
    DMA_T(0, 0); DMA_T(1, SLOTB);
    float mref = 0.f, l_reg = 0.f; f32x16 o[4]; o[0] = f32x16{}; o[1] = f32x16{}; o[2] = f32x16{}; o[3] = f32x16{};
    f32x16 negm = f32x16{};
    int sl_cur = 0, sl_nn = 2 * SLOTB;
    for (int t = 0; t < NT; ++t) {
        if (t + 1 < NT) { WAIT_BAR(4); } else { WAIT_BAR(0); }
        if (t + 2 < NT) DMA_T(t + 2, sl_nn);
        if (t < myNT) {
            const DLAS unsigned char* kp = kp0 + sl_cur; const DLAS unsigned char* vp = vp0 + sl_cur;
            f32x16 p0 = negm, p1 = negm;
#pragma unroll
            for (int d0 = 0; d0 < 4; ++d0) {
                const bf16x8 k0 = *(const DLAS bf16x8*)(kp + d0 * 2048), k1 = *(const DLAS bf16x8*)(kp + d0 * 2048 + 512);
                p0 = MFMA32(k0, qr[d0], p0); p1 = MFMA32(k1, qr[d0], p1);
            }
            const float rm = rowmax(p0, p1);
            if (t == 0 || __any(rm > THR)) {
                const float dl = (t == 0) ? rm : __builtin_fmaxf(rm, 0.f);
                mref += dl;
#pragma unroll
                for (int r = 0; r < 16; ++r) { p0[r] -= dl; p1[r] -= dl; }
#pragma unroll
                for (int r = 0; r < 16; ++r) negm[r] = -mref;
                if (t != 0) {
                    const float f = __builtin_amdgcn_exp2f(-dl); l_reg *= f;
                    if (hi == 0) wsf[r32] = f;
                    asm volatile("s_waitcnt lgkmcnt(0)" ::: "memory");
                    float a[16];
#pragma unroll
                    for (int r = 0; r < 16; ++r) a[r] = wsf[crow(r, hi)];
#pragma unroll
                    for (int d = 0; d < 4; ++d)
#pragma unroll
                        for (int r = 0; r < 16; ++r) o[d][r] *= a[r];
                }
            }
            float sacc = 0.f;
#pragma unroll
            for (int r = 0; r < 16; ++r) { p0[r] = __builtin_amdgcn_exp2f(p0[r]); p1[r] = __builtin_amdgcn_exp2f(p1[r]); sacc += p0[r] + p1[r]; }
            l_reg += sacc;
            u32x4 pw[4];
            pw[0] = (u32x4){cvtpk(p0[0], p0[1]), cvtpk(p0[2], p0[3]), cvtpk(p0[4], p0[5]), cvtpk(p0[6], p0[7])};
            pw[1] = (u32x4){cvtpk(p0[8], p0[9]), cvtpk(p0[10], p0[11]), cvtpk(p0[12], p0[13]), cvtpk(p0[14], p0[15])};
            pw[2] = (u32x4){cvtpk(p1[0], p1[1]), cvtpk(p1[2], p1[3]), cvtpk(p1[4], p1[5]), cvtpk(p1[6], p1[7])};
            pw[3] = (u32x4){cvtpk(p1[8], p1[9]), cvtpk(p1[10], p1[11]), cvtpk(p1[12], p1[13]), cvtpk(p1[14], p1[15])};
#pragma unroll
            for (int dq = 0; dq < 4; ++dq) {
#pragma unroll
                for (int ks = 0; ks < 4; ++ks) {
                    const s16x4 lo = vtr(vp + dq * 4096 + ks * 1024), hh = vtr(vp + dq * 4096 + ks * 1024 + 512);
                    const bf16x8 vf = (bf16x8){lo[0], lo[1], lo[2], lo[3], hh[0], hh[1], hh[2], hh[3]};
                    o[dq] = MFMA32(__builtin_bit_cast(bf16x8, pw[ks]), vf, o[dq]);
                }
            }
        }
        sl_cur = (sl_cur == 2 * SLOTB) ? 0 : sl_cur + SLOTB; sl_nn = (sl_nn == 2 * SLOTB) ? 0 : sl_nn + SLOTB;
    }
    { auto rr = __builtin_amdgcn_permlane32_swap(__float_as_uint(l_reg), __float_as_uint(l_reg), false, false); l_reg = __uint_as_float(rr[0]) + __uint_as_float(rr[1]); }
    if (hi == 0) wsf[32 + r32] = l_reg;
    asm volatile("s_waitcnt lgkmcnt(0)" ::: "memory");
    float rli[16];
#pragma unroll
    for (int r = 0; r < 16; ++r) rli[r] = __builtin_amdgcn_rcpf(wsf[32 + crow(r, hi)]);
    BAR_ALL();
    DLAS float* st = (DLAS float*)shm;
#pragma unroll
    for (int r = 0; r < 16; ++r) { const int row = map * 128 + rq * 32 + crow(r, hi);
#pragma unroll
        for (int dq = 0; dq < 4; ++dq) st[row * 128 + dq * 32 + r32] = o[dq][r] * rli[r]; }
    BAR_ALL();
#pragma unroll
    for (int ps = 0; ps < 4; ++ps) {
        const int item = ps * 512 + tid, row = item >> 4, ch = item & 15;
        const DLAS f32x4* p1 = (const DLAS f32x4*)(st + row * 128 + ch * 8); const DLAS f32x4* p2 = (const DLAS f32x4*)(st + 16384 + row * 128 + ch * 8);
        const f32x4 o0 = p1[0] - p2[0] * lam, o1 = p1[1] - p2[1] * lam;
        float ss = ((o0[0] * o0[0] + o0[1] * o0[1]) + (o0[2] * o0[2] + o0[3] * o0[3])) + ((o1[0] * o1[0] + o1[1] * o1[1]) + (o1[2] * o1[2] + o1[3] * o1[3]));
        ss += __shfl_xor(ss, 1); ss += __shfl_xor(ss, 2); ss += __shfl_xor(ss, 4); ss += __shfl_xor(ss, 8);
        const float rinv = __builtin_amdgcn_rsqf(ss * (1.0f / 128.0f) + 1e-5f) * 0.8f;
        const size_t gi = (size_t)(rowbase + q0 + row) * DM + h * 128 + ch * 8;
        const u32x4 g0v = *(const u32x4*)(G0 + gi), gmv = *(const u32x4*)(GM + gi);
        const f32x4 sg0 = *(const f32x4*)(subln_g + ch * 8), sg1 = *(const f32x4*)(subln_g + ch * 8 + 4);
        float y[8];
#pragma unroll
        for (int i = 0; i < 4; ++i) { y[i] = o0[i] * rinv * sg0[i]; y[4 + i] = o1[i] * rinv * sg1[i]; }
        u32x4 w;
#pragma unroll
        for (int i = 0; i < 4; ++i) {
            const unsigned gg = g0v[i], mm = gmv[i];
            const float lo = __uint_as_float(gg << 16) * y[2 * i] + __uint_as_float(mm << 16), hh = __uint_as_float(gg & 0xffff0000u) * y[2 * i + 1] + __uint_as_float(mm & 0xffff0000u);
            w[i] = cvtpk(lo, hh);
        }
        *(u32x4*)(MERGED + gi) = w;
    }
    BAR_ALL();
#undef DMA_T
#undef RFL
}

__device__ __forceinline__ void gmlp_unit(int b, int n, int g, const bf16_t* GV, const bf16_t* GU, const bf16_t* G1, const float* gvss, const bf16_t* Wp, const float* bs, bf16_t* GM,
                                          DLAS unsigned char* shm) {
    const int tid = threadIdx.x, lane = tid & 63, r32 = lane & 31, hi = lane >> 5; const int wid = __builtin_amdgcn_readfirstlane(tid >> 6);
    const long rowbase = (long)b * SEQ + n * 128;
    DLAS float* rin = (DLAS float*)(shm + 32768);
    if (tid < 128) { const f32x4* sp = (const f32x4*)(gvss + (size_t)(rowbase + tid) * 16); const f32x4 t = (sp[0] + sp[1]) + (sp[2] + sp[3]);
        rin[tid] = __builtin_amdgcn_rsqf(((t[0] + t[1]) + (t[2] + t[3])) * (1.0f / 1024.0f) + 1e-6f); }
    __syncthreads();
#pragma unroll
    for (int it = 0; it < 4; ++it) {
        const int item = it * 512 + tid, row = item >> 4, c16 = item & 15;
        const u32x4 v = *(const u32x4*)(GV + (size_t)(rowbase + row) * DM + g * 128 + c16 * 8); const float ri = rin[row];
        u32x4 w;
#pragma unroll
        for (int i = 0; i < 4; ++i) w[i] = cvtpk(__uint_as_float(v[i] << 16) * ri, __uint_as_float(v[i] & 0xffff0000u) * ri);
        *(DLAS u32x4*)(shm + (c16 >> 2) * 8192 + row * 64 + (c16 & 3) * 16) = w;
    }
    __syncthreads();
    const int ib = wid >> 1, cb0 = 2 * (wid & 1), nks = (ib < 2) ? 4 : 8;
    const DLAS unsigned char* vp0 = shm + ((lane >> 4) & 1) * 32 + (lane & 3) * 8 + (4 * hi + ((lane & 15) >> 2)) * 64;
    const bf16_t* wrow = Wp + ((size_t)(g * 128 + ib * 32 + r32)) * 128 + hi * 8;
    f32x16 acc[2]; acc[0] = f32x16{}; acc[1] = f32x16{};
    for (int ks = 0; ks < nks; ++ks) {
        const bf16x8 a = *(const bf16x8*)(wrow + ks * 16);
#pragma unroll
        for (int c = 0; c < 2; ++c) {
            const s16x4 lo = vtr(vp0 + (cb0 + c) * 8192 + ks * 1024), hh = vtr(vp0 + (cb0 + c) * 8192 + ks * 1024 + 512);
            const bf16x8 vf = (bf16x8){lo[0], lo[1], lo[2], lo[3], hh[0], hh[1], hh[2], hh[3]};
            acc[c] = MFMA32(a, vf, acc[c]);
        }
    }
#pragma unroll
    for (int c = 0; c < 2; ++c)
#pragma unroll
        for (int r = 0; r < 16; ++r) {
            const int i = ib * 32 + crow(r, hi); const size_t idx = (size_t)(rowbase + i) * DM + g * 128 + (cb0 + c) * 32 + r32;
            const float mixed = acc[c][r] + bs[g * 128 + i];
            const float gm = bf2f(GU[idx]) * mixed * bf2f(G1[idx]);
            GM[idx] = (bf16_t)(cvtpk(gm, 0.f) & 0xffffu);
        }
    __syncthreads();
}
#undef MX3
#undef MFMA32
#undef WAIT_BAR
#undef BAR_ALL
}

#ifndef STOP_AFTER
#define STOP_AFTER 0
#endif
constexpr int NWAVES = 8;
constexpr int M = 16 * 2048, D = 1024, DIN = 7168, DFF = 2816;
constexpr size_t MiB = 1u << 20;
constexpr size_t WS_CTL = 0, CTL_ZERO_BYTES = 1 * MiB;
constexpr size_t WS_WIN = 2 * MiB, WS_WOUT = 16 * MiB, WS_WFFI = 18 * MiB, WS_WFFO = 29 * MiB, WS_WSP = 35 * MiB, WS_ROPE = 36 * MiB;
constexpr size_t WS_SS0 = 38 * MiB, WS_SS1 = 40 * MiB, WS_SS2 = 42 * MiB;
constexpr size_t WS_XN = 48 * MiB, WS_Q = 112 * MiB, WS_K = 176 * MiB, WS_V = 240 * MiB, WS_GU = 304 * MiB, WS_GV = 368 * MiB, WS_END = 432 * MiB;
static_assert(WS_WFFO + (size_t)D * DFF * 2 <= WS_WSP && WS_K + (size_t)M * DFF * 2 <= WS_GV, "d_ws map");
constexpr int CW_BAR = 4096;
constexpr int RING_OFF = 0, RING_BYTES = 131072;
constexpr int LDSCTL_OFF = RING_BYTES, MISC_OFF = LDSCTL_OFF + 320, WSF_OFF = LDSCTL_OFF + 4096;
constexpr int LDS_BYTES = 147456;
#define GAS __attribute__((address_space(1)))
#define LAS __attribute__((address_space(3)))
typedef unsigned short bf16;
typedef unsigned v4u __attribute__((ext_vector_type(4)));
typedef float f32x4 __attribute__((ext_vector_type(4)));
typedef short bf16x8 __attribute__((ext_vector_type(8)));
typedef GAS unsigned gu32;
typedef GAS unsigned long long gu64;
#define RLX_AGENT __ATOMIC_RELAXED, __HIP_MEMORY_SCOPE_AGENT
#define LDS_WAIT() asm volatile("s_waitcnt lgkmcnt(0)" ::: "memory")
#define VM_WAIT() asm volatile("s_waitcnt vmcnt(0)" ::: "memory")
__device__ __forceinline__ unsigned long long rt() { return __builtin_amdgcn_s_memrealtime(); }
__device__ __forceinline__ unsigned f2bf(float f) { unsigned u = __builtin_bit_cast(unsigned, f); return (u + 0x7fffu + ((u >> 16) & 1u)) >> 16; }
__device__ __forceinline__ unsigned pk2(float lo, float hi) { return f2bf(lo) | (f2bf(hi) << 16); }

#define XB_TMO      128
#define XB_XCNT(j)  (256  + 64 * (j))
#define XB_XSUB(j)  (1280 + 64 * (j))
#define XB_XGEN(j)  (2304 + 64 * (j))
#define XB_TOP      3328
#define XB_TOPGEN   3392
#define XCD_BAR_WORDS 3456
#define XB_SPIN_CAP (1u << 18)

__device__ __forceinline__ unsigned xb_ld(unsigned* p)              { return __hip_atomic_load(p, __ATOMIC_RELAXED, __HIP_MEMORY_SCOPE_AGENT); }
__device__ __forceinline__ unsigned xb_add(unsigned* p, unsigned v) { return __hip_atomic_fetch_add(p, v, __ATOMIC_RELAXED, __HIP_MEMORY_SCOPE_AGENT); }
__device__ __forceinline__ unsigned xb_xcc_id() { return (unsigned)__builtin_amdgcn_s_getreg((3 << 11) | 20) & 0xFu; }
#define XB_SPIN(cond, bar) do { unsigned _sp = 0; while (cond) { __builtin_amdgcn_s_sleep(1); \
    if ((++_sp & 255u) == 0u) { if (xb_ld(&(bar)[XB_TMO])) break; if (_sp > XB_SPIN_CAP) { atomicAdd(&(bar)[XB_TMO], 1u); break; } } } } while (0)

struct XcdBarrier {
    unsigned* bar; unsigned x;
    volatile LAS unsigned* st;
};

__device__ __forceinline__ XcdBarrier xcd_barrier_post(unsigned* bar, volatile LAS unsigned* st) {
    XcdBarrier b; b.bar = bar; b.x = xb_xcc_id(); b.st = st;
    if (threadIdx.x == 0) (void)xb_add(&bar[XB_XCNT(b.x)], 1u);
    return b;
}
__device__ __forceinline__ void xcd_barrier_complete(unsigned* bar, unsigned x, unsigned& nloc, unsigned& nx) {
    const unsigned G = gridDim.x * gridDim.y * gridDim.z;
    unsigned sum, cnt, mine, sp = 0u;
    for (;;) {
        sum = 0u; cnt = 0u; mine = 0u;
#pragma unroll
        for (unsigned j = 0; j < 16; ++j) { const unsigned c = xb_ld(&bar[XB_XCNT(j)]); sum += c; cnt += (c > 0u) ? 1u : 0u; mine = (j == x) ? c : mine; }
        if (sum == G) break;
        __builtin_amdgcn_s_sleep(1);
        if ((++sp & 255u) == 0u) { if (xb_ld(&bar[XB_TMO])) break; if (sp > XB_SPIN_CAP) { atomicAdd(&bar[XB_TMO], 1u); break; } }
    }
    nloc = mine > 0u ? mine : 1u; nx = cnt > 0u ? cnt : 1u;
}

__device__ __forceinline__ void xcd_barrier(const XcdBarrier& b) {
    asm volatile("s_waitcnt vmcnt(0)" ::: "memory");
    __syncthreads();
    if (threadIdx.x == 0) {
        unsigned* bar = b.bar;
        __builtin_amdgcn_s_waitcnt(0);
        unsigned nloc = b.st[0], nx = b.st[1];
        if (nloc == 0u) { xcd_barrier_complete(bar, b.x, nloc, nx); b.st[0] = nloc; b.st[1] = nx; }
        const unsigned old = xb_add(&bar[XB_XSUB(b.x)], 1u);
        const unsigned gen = old / nloc;
        if (old + 1u == (gen + 1u) * nloc) {
            __builtin_amdgcn_fence(__ATOMIC_RELEASE, "agent");
            asm volatile("s_waitcnt vmcnt(0)" ::: "memory");
            const unsigned og = xb_add(&bar[XB_TOP], 1u);
            const unsigned tg = og / nx;
            if (og + 1u == (tg + 1u) * nx) xb_add(&bar[XB_TOPGEN], 1u);
            else XB_SPIN(xb_ld(&bar[XB_TOPGEN]) == tg, bar);
            __builtin_amdgcn_fence(__ATOMIC_ACQUIRE, "agent");
            xb_add(&bar[XB_XGEN(b.x)], 1u);
            asm volatile("s_waitcnt vmcnt(0)" ::: "memory");
        } else {
            XB_SPIN(xb_ld(&bar[XB_XGEN(b.x)]) == gen, bar);
            __builtin_amdgcn_fence(__ATOMIC_ACQUIRE, "agent");
            asm volatile("s_waitcnt vmcnt(0)" ::: "memory");
        }
    }
    __syncthreads();
}
struct Frame {
    LAS unsigned char* lds;
    volatile LAS unsigned* MISC;
    gu32* ctl;
    int tid, lane, wave;
    int vcu, G;
};

__device__ __forceinline__ float wave_sum(float v) {
#pragma unroll
    for (int o = 1; o < 64; o <<= 1) v += __shfl_xor(v, o);
    return v;
}
__device__ __forceinline__ void p0_transpose_item(const float* W, int K, int N, bf16* WT, int n0d, int n0s, int k0, const float* kscale, LAS float* scr, int lane) {
#pragma unroll 8
    for (int i = 0; i < 32; ++i) { const int kk = 2 * i + (lane >> 5); float v = W[(size_t)(k0 + kk) * N + n0s + (lane & 31)]; if (kscale) v *= kscale[k0 + kk]; scr[kk * 33 + (lane & 31)] = v; }
    LDS_WAIT(); asm volatile("" ::: "memory");
    const int c = lane & 7;
#pragma unroll
    for (int j = 0; j < 4; ++j) { const int n = (lane >> 3) + 8 * j; const LAS float* s = scr + (8 * c) * 33 + n;
        v4u o; o.x = pk2(s[0 * 33], s[1 * 33]); o.y = pk2(s[2 * 33], s[3 * 33]); o.z = pk2(s[4 * 33], s[5 * 33]); o.w = pk2(s[6 * 33], s[7 * 33]);
        *(GAS v4u*)(WT + (size_t)(n0d + n) * K + k0 + 8 * c) = o; }
    LDS_WAIT(); asm volatile("" ::: "memory");
}

struct Args { const float* in[15]; float* out; unsigned char* ws; };

__global__ void __launch_bounds__(NWAVES * 64, 2) skel_fwd(Args args) {
    extern __shared__ __attribute__((aligned(16))) unsigned char lds[];
    Frame F;
    F.lds = (LAS unsigned char*)lds;
    F.MISC = (volatile LAS unsigned*)(F.lds + MISC_OFF);
    F.tid = threadIdx.x; F.lane = F.tid & 63; F.wave = __builtin_amdgcn_readfirstlane(F.tid >> 6);
    F.G = gridDim.x; { const int bx = blockIdx.x; F.vcu = (F.G % 8 == 0) ? (bx % 8) * (F.G / 8) + bx / 8 : bx; }
    unsigned char* ws = args.ws;
    F.ctl = (gu32*)(ws + WS_CTL);
    const float* x = args.in[0]; const int* positions = (const int*)args.in[1]; const float* norm_mix_g = args.in[2]; const float* w_in = args.in[3];
    const float* gate_b = args.in[4]; const float* lambdas = args.in[5]; const float* subln_g = args.in[6]; const float* gm_norm_g = args.in[7];
    const float* gm_ws = args.in[8]; const float* gm_bs = args.in[9]; const float* w_out = args.in[10]; const float* norm_ffn_g = args.in[11];
    const float* w_ffn_in = args.in[12]; const float* w_ffn_out = args.in[13]; const float* norm_final_g = args.in[14];
    float* out = args.out;
    bf16* Win_t = (bf16*)(ws + WS_WIN); bf16* Wout_t = (bf16*)(ws + WS_WOUT); bf16* Wffi_t = (bf16*)(ws + WS_WFFI); bf16* Wffo_t = (bf16*)(ws + WS_WFFO);
    bf16* Wsp = (bf16*)(ws + WS_WSP); float* rope = (float*)(ws + WS_ROPE);
    float* gvss = (float*)(ws + WS_SS0); float* x1ss = (float*)(ws + WS_SS1); float* x2ss = (float*)(ws + WS_SS2);
    bf16* XN = (bf16*)(ws + WS_XN); bf16* GMB = (bf16*)(ws + WS_XN);
    bf16* QB_ = (bf16*)(ws + WS_Q); bf16* KB = (bf16*)(ws + WS_K); bf16* VB = (bf16*)(ws + WS_V); bf16* GU = (bf16*)(ws + WS_GU); bf16* GV = (bf16*)(ws + WS_GV);
    bf16* MERGED = (bf16*)(ws + WS_GU);
    bf16* G0 = (bf16*)out; bf16* G1 = (bf16*)out + (size_t)M * D;
    bf16* X1B = (bf16*)(ws + WS_Q);
    bf16* ACT = (bf16*)(ws + WS_K);

    for (int u = F.tid; u < (LDS_BYTES - LDSCTL_OFF) / 4; u += NWAVES * 64) ((LAS unsigned*)(F.lds + LDSCTL_OFF))[u] = 0u;
    __syncthreads();
    XcdBarrier bar = xcd_barrier_post((unsigned*)(F.ctl + CW_BAR), F.MISC + 8);
    const int gw = F.vcu * NWAVES + F.wave, NGW = F.G * NWAVES;

    {
        LAS float* scr = (LAS float*)(F.lds + RING_OFF + F.wave * 16384);
        constexpr int I_IN = (D / 64) * (DIN / 32), I_OUT = (D / 64) * (D / 32), I_FFI = (D / 64) * (2 * DFF / 32), I_FFO = (DFF / 64) * (D / 32);
        constexpr int NITEMS = I_IN + I_OUT + I_FFI + I_FFO;
        for (int it = gw; it < NITEMS; it += NGW) {
            int r = it;
            if (r < I_IN) { const int nblk = DIN / 32, kb = r / nblk, nb = r % nblk; p0_transpose_item(w_in, D, DIN, Win_t, 32 * nb, 32 * nb, 64 * kb, nullptr, scr, F.lane); continue; } r -= I_IN;
            if (r < I_OUT) { const int nblk = D / 32, kb = r / nblk, nb = r % nblk; p0_transpose_item(w_out, D, D, Wout_t, 32 * nb, 32 * nb, 64 * kb, nullptr, scr, F.lane); continue; } r -= I_OUT;
            if (r < I_FFI) { const int nblk = 2 * DFF / 32, kb = r / nblk, nb = r % nblk; const int n0d = 32 * nb, j = n0d >> 8, c = n0d & 255;
                const int n0s = (c < 128) ? 128 * j + c : DFF + 128 * j + (c - 128);
                p0_transpose_item(w_ffn_in, D, 2 * DFF, Wffi_t, n0d, n0s, 64 * kb, norm_ffn_g, scr, F.lane); continue; } r -= I_FFI;
            { const int nblk = D / 32, kb = r / nblk, nb = r % nblk; p0_transpose_item(w_ffn_out, DFF, D, Wffo_t, 32 * nb, 32 * nb, 64 * kb, nullptr, scr, F.lane); }
        }
        for (int e = (int)blockIdx.x * (NWAVES * 64) + F.tid; e < 8 * 128 * 128; e += F.G * NWAVES * 64) {
            const int jp = e & 127, i = (e >> 7) & 127, g = e >> 14; const int ks = jp >> 4, hh = (jp >> 3) & 1, jj = jp & 7; const int j = 16 * ks + 8 * (jj >> 2) + 4 * hh + (jj & 3);
            const float v = ((j >> 6) <= (i >> 6)) ? gm_ws[(size_t)(g * 128 + i) * 128 + j] : 0.f;
            Wsp[e] = (bf16)f2bf(v);
        }
        for (int e = (int)blockIdx.x * (NWAVES * 64) + F.tid; e < M * 8; e += F.G * NWAVES * 64) {
            const int m = e >> 3, i = e & 7;
            const float fr = (i == 0) ? 1.0f : (i == 1) ? 0.1939227432012558f : (i == 2) ? 0.03760603070259094f : (i == 3) ? 0.007292664609849453f : (i == 4) ? 0.0014142135623842478f
                           : (i == 5) ? 0.00027424818836152554f : (i == 6) ? 5.318296098266728e-05f : 1.0313386155758053e-05f;
            const float ang = (float)positions[m] * fr;
            const double tt = (double)ang * 0.15915494309189535; const float tf = (float)(tt - __builtin_rint(tt));
            rope[(size_t)m * 16 + i] = __builtin_amdgcn_cosf(tf); rope[(size_t)m * 16 + 8 + i] = __builtin_amdgcn_sinf(tf);
        }
        for (int m = gw; m < M; m += NGW) {
            const GAS f32x4* xr = (const GAS f32x4*)(x + (size_t)m * D) + F.lane; f32x4 v[4]; float s = 0.f;
#pragma unroll
            for (int j = 0; j < 4; ++j) { v[j] = xr[64 * j]; s += (v[j].x * v[j].x + v[j].y * v[j].y) + (v[j].z * v[j].z + v[j].w * v[j].w); }
            const float rinv = __builtin_amdgcn_rsqf(wave_sum(s) * (1.f / D) + 1e-6f);
            GAS unsigned long long* o8 = (GAS unsigned long long*)(XN + (size_t)m * D) + F.lane;
#pragma unroll
            for (int j = 0; j < 4; ++j) { const f32x4 gg = *((const f32x4*)norm_mix_g + F.lane + 64 * j);
                o8[64 * j] = (unsigned long long)pk2(v[j].x * rinv * gg.x, v[j].y * rinv * gg.y) | ((unsigned long long)pk2(v[j].z * rinv * gg.z, v[j].w * rinv * gg.w) << 32); }
        }
    }
    xcd_barrier(bar);

#if STOP_AFTER == 10
    { const size_t n = (size_t)M * D; for (size_t i = (size_t)blockIdx.x * 512 + F.tid; i < n; i += (size_t)F.G * 512)
        out[i] = pg8::bf2f(XN[i]) + pg8::bf2f(Win_t[i % ((size_t)DIN * D)]) + pg8::bf2f(Wffi_t[i % ((size_t)2 * DFF * D)]) + pg8::bf2f(Wffo_t[i % ((size_t)DFF * D)]) + pg8::bf2f(Wout_t[i % ((size_t)D * D)]) + rope[i % ((size_t)M * 16)] + pg8::bf2f(Wsp[i % 131072]); }
    return;
#endif
    {
        pg8::Gemm g{XN, Win_t, M, DIN, D}; pg8::StaticOrder S; S.init(M, DIN, F.G, (int)blockIdx.x);
        pg8::EpiProj E; E.dst5 = QB_; E.dstg = G0;
        E.rope = rope; E.gate_b = gate_b; E.gnorm = gm_norm_g; E.gvss = gvss; E.qscale = dattn::C2;
        pg8::gemm_phase<pg8::EpiProj, pg8::StaticOrder, true, true>(F.lds + RING_OFF, g, S, E);
    }
    xcd_barrier(bar);
#if STOP_AFTER == 1
    { const size_t n = (size_t)M * D; const unsigned* gp = (const unsigned*)out;
      for (size_t i = (size_t)blockIdx.x * 512 + F.tid; i < n; i += (size_t)F.G * 512) { const unsigned g2 = gp[i];
        out[i] = __uint_as_float(g2 << 16) + __uint_as_float(g2 & 0xffff0000u) + pg8::bf2f(QB_[i]) + pg8::bf2f(KB[i]) + pg8::bf2f(VB[i]) + pg8::bf2f(GU[i]) + pg8::bf2f(GV[i]) + gvss[i & ((size_t)M * 16 - 1)] * 0.001f; } }
    return;
#endif

    {
        const int per = (2048 + F.G - 1) / F.G;
        for (int i = 0; i < per; ++i) { const int id = F.vcu * per + i; if (id < 2048) dattn::gmlp_unit(id >> 7, (id >> 3) & 15, id & 7, GV, GU, G1, gvss, Wsp, gm_bs, GMB, F.lds + RING_OFF); }
    }
    xcd_barrier(bar);
#if STOP_AFTER == 2
    { const size_t n = (size_t)M * D; for (size_t i = (size_t)blockIdx.x * 512 + F.tid; i < n; i += (size_t)F.G * 512) out[i] = pg8::bf2f(GMB[i]); }
    return;
#endif

    {
        const float a = lambdas[F.lane] * lambdas[64 + F.lane], c = lambdas[128 + F.lane] * lambdas[192 + F.lane];
        const float lam = __expf(wave_sum(a)) - __expf(wave_sum(c)) + 0.2f;
        const int per = (1024 + F.G - 1) / F.G;
        for (int j = 0; j < per; ++j) { const int pr = F.vcu * per + j; if (pr >= 1024) break; const int bh = pr >> 3, s = pr & 7;
            for (int k = 0; k < 2; ++k) dattn::unit(bh >> 3, bh & 7, k ? 15 - s : s, QB_, KB, VB, G0, GMB, MERGED, subln_g, lam, F.lds + RING_OFF, (LAS float*)(F.lds + WSF_OFF)); }
    }
    xcd_barrier(bar);
#if STOP_AFTER == 3
    { const size_t n = (size_t)M * D; for (size_t i = (size_t)blockIdx.x * 512 + F.tid; i < n; i += (size_t)F.G * 512) out[i] = pg8::bf2f(MERGED[i]); }
    return;
#endif

    {
        pg8::Gemm g{MERGED, Wout_t, M, D, D}; pg8::StaticOrder S; S.init(M, D, F.G, (int)blockIdx.x);
        pg8::EpiResid E{x, out, X1B, x1ss};
        pg8::gemm_phase<pg8::EpiResid, pg8::StaticOrder, true, true>(F.lds + RING_OFF, g, S, E);
    }
    xcd_barrier(bar);
#if STOP_AFTER == 4
    return;
#endif

    {
        pg8::Gemm g{X1B, Wffi_t, M, 2 * DFF, D}; pg8::StaticOrder S; S.init(M, 2 * DFF, F.G, (int)blockIdx.x);
        pg8::EpiSwiglu E{ACT, x1ss, DFF};
        pg8::gemm_phase<pg8::EpiSwiglu, pg8::StaticOrder, true, true>(F.lds + RING_OFF, g, S, E);
    }
    xcd_barrier(bar);
#if STOP_AFTER == 5
    { const size_t n = (size_t)M * D; for (size_t i = (size_t)blockIdx.x * 512 + F.tid; i < n; i += (size_t)F.G * 512) out[i] = pg8::bf2f(ACT[i]) + pg8::bf2f(ACT[i + n]); }
    return;
#endif

    {
        pg8::Gemm g{ACT, Wffo_t, M, D, DFF}; pg8::StaticOrder S; S.init(M, D, F.G, (int)blockIdx.x);
        pg8::EpiResid E{out, out, nullptr, x2ss};
        pg8::gemm_phase<pg8::EpiResid, pg8::StaticOrder, true, true>(F.lds + RING_OFF, g, S, E);
    }
    xcd_barrier(bar);

    {
        const unsigned poison = xb_ld((unsigned*)(F.ctl + CW_BAR) + XB_TMO);
        for (int m = gw; m < M; m += NGW) {
            GAS f32x4* xr = (GAS f32x4*)(out + (size_t)m * D) + F.lane; f32x4 v[4];
#pragma unroll
            for (int j = 0; j < 4; ++j) v[j] = xr[64 * j];
            float s = x2ss[(size_t)m * 16 + (F.lane & 15)];
            s += __shfl_xor(s, 1); s += __shfl_xor(s, 2); s += __shfl_xor(s, 4); s += __shfl_xor(s, 8);
            float rinv = __builtin_amdgcn_rsqf(s * (1.f / D) + 1e-6f);
            if (poison) rinv = __builtin_nanf("");
#pragma unroll
            for (int j = 0; j < 4; ++j) { const f32x4 gg = *((const f32x4*)norm_final_g + F.lane + 64 * j); xr[64 * j] = v[j] * rinv * gg; }
        }
    }
}

extern "C" void kernel_launch(void* const* d_in, const int* in_sizes, int n_in, void* d_out, int out_size, void* d_ws, size_t ws_size, hipStream_t stream) {
    static int grid = 0;
    if (grid == 0) {
        if (n_in != 15 || in_sizes[0] != M * D || out_size != M * D || ws_size < WS_END) { fprintf(stderr, "kernel_launch: unexpected shapes (n_in %d, in0 %d, out %d, ws %zu < %zu); nothing launched\n", n_in, n_in > 0 ? in_sizes[0] : -1, out_size, ws_size, (size_t)WS_END); grid = -1; return; }
        int dev = 0, cus = 0;
        if (hipGetDevice(&dev) != hipSuccess || hipDeviceGetAttribute(&cus, hipDeviceAttributeMultiprocessorCount, dev) != hipSuccess) { fprintf(stderr, "kernel_launch: device query failed\n"); grid = -1; return; }
        if (hipFuncSetAttribute((const void*)skel_fwd, hipFuncAttributeMaxDynamicSharedMemorySize, LDS_BYTES) != hipSuccess) { fprintf(stderr, "kernel_launch: hipFuncSetAttribute failed\n"); grid = -1; return; }
        int per_cu = 0;
        if (hipOccupancyMaxActiveBlocksPerMultiprocessor(&per_cu, (const void*)skel_fwd, NWAVES * 64, LDS_BYTES) != hipSuccess || per_cu < 1) fprintf(stderr, "kernel_launch: note: occupancy query reports %d\n", per_cu);
        (void)hipGetLastError();
        grid = cus;
        if (grid != 256) fprintf(stderr, "kernel_launch: %d CUs; the unit dealing assumes 256\n", grid);
    }
    if (grid < 0) return;
    if (hipMemsetAsync((char*)d_ws + WS_CTL, 0, CTL_ZERO_BYTES, stream) != hipSuccess) { fprintf(stderr, "kernel_launch: hipMemsetAsync failed\n"); return; }
    Args a{};
    for (int i = 0; i < 15; ++i) a.in[i] = (const float*)d_in[i];
    a.out = (float*)d_out; a.ws = (unsigned char*)d_ws;
    hipLaunchKernelGGL(skel_fwd, dim3(grid), dim3(NWAVES * 64), LDS_BYTES, stream, a);
    const hipError_t le = hipPeekAtLastError();
    if (le != hipSuccess) fprintf(stderr, "kernel_launch: launch failed: %s\n", hipGetErrorName(le));
}
```

```cpp
#include <hip/hip_runtime.h>
#include <cstdio>
#include <cstdint>
#ifndef EPI_PLAIN
#define EPI_PLAIN 0
#endif
namespace pg8 {
#define PG8_LAS __attribute__((address_space(3)))
typedef unsigned short bf16_t;
typedef short bf16x8 __attribute__((ext_vector_type(8)));
typedef float f32x4 __attribute__((ext_vector_type(4)));
typedef unsigned u32x4 __attribute__((ext_vector_type(4)));
constexpr int BM = 256, BK = 64, HALF = 128, HTB = HALF * BK * 2  , STAGE_BYTES = 8 * HTB, NXCD = 8, WGM = 8;

__host__ __device__ __forceinline__ int lds_byte(int r, int c) { const int st = (r >> 4) * 2 + (c >> 5), rr = r & 15, cc = c & 31, ob = rr * 64 + cc * 2; return st * 1024 + (ob ^ (((ob >> 9) & 1) << 5)); }
__host__ __device__ __forceinline__ void stage_rc(int b, int& R, int& C) { const int st = b / 1024, sb = b % 1024, swz = sb ^ (((sb >> 9) & 1) << 5); R = (st >> 1) * 16 + swz / 64; C = (st & 1) * 32 + (swz % 64) / 2; }
__host__ __device__ __forceinline__ int perm32(int rho) { const int n = rho >> 4, i = rho & 15; return 8 * (i >> 2) + 4 * n + (i & 3); }

struct Unit { int pm, pn; };
struct Gemm { const bf16_t* A; const bf16_t* Bt; int M, N, K; };

struct StaticOrder {
    int nM, nN, nwg, G, c;
    __host__ __device__ void init(int M, int N, int G_, int c_) { nM = M / BM; nN = N / BM; nwg = nM * nN; G = G_; c = c_; }
    __host__ __device__ bool next(int i, Unit& u) const {
        const long L = (long)i * G + c; if (L >= nwg) return false;
        int wgid = (int)L; { const int q = nwg / NXCD, r = nwg % NXCD, xcd = wgid % NXCD, off = wgid / NXCD; wgid = (xcd < r ? xcd * (q + 1) : r * (q + 1) + (xcd - r) * q) + off; }
        const int nig = WGM * nN, gid = wgid / nig, fm = gid * WGM, gsz = (nM - fm) < WGM ? (nM - fm) : WGM;
        u.pm = fm + ((wgid % nig) % gsz); u.pn = (wgid % nig) / gsz; return true;
    }
    __device__ __forceinline__ void a_ready(const Unit&) const {}
    __device__ __forceinline__ void done(const Unit&) const {}
};

typedef float f32x2c_t __attribute__((ext_vector_type(2))); typedef __bf16 bf16x2c_t __attribute__((ext_vector_type(2)));
__device__ __forceinline__ unsigned cvt_pk_bf16(float lo, float hi) { f32x2c_t v = {lo, hi}; bf16x2c_t b = __builtin_convertvector(v, bf16x2c_t); return __builtin_bit_cast(unsigned, b); }
typedef float f32x2 __attribute__((ext_vector_type(2)));
__device__ __forceinline__ f32x2 gelu_pk(f32x2 v) {
    const f32x2 av = __builtin_elementwise_abs(v), d = av * 0.2316418882f + 1.0f;
    f32x2 t; t.x = __builtin_amdgcn_rcpf(d.x); t.y = __builtin_amdgcn_rcpf(d.y);
    f32x2 q = t * 0.5307027145f + (-0.7265760135f); q = q * t + 0.7107068705f; q = q * t + (-0.142248368f); q = q * t + 0.127414796f; q = q * t;
    const f32x2 s = (v * v) * (-0.72134752044f);
    f32x2 e; e.x = __builtin_amdgcn_exp2f(s.x); e.y = __builtin_amdgcn_exp2f(s.y);
    const f32x2 m = v * (q * e), r = v - m;
    f32x2 o; o.x = v.x < 0.f ? m.x : r.x; o.y = v.y < 0.f ? m.y : r.y; return o;
}

__device__ __forceinline__ float bf2f(unsigned short h) { return __uint_as_float((unsigned)h << 16); }
__device__ __forceinline__ float sigm(float x) { return __builtin_amdgcn_rcpf(1.0f + __builtin_amdgcn_exp2f(-1.4426950408889634f * x)); }
__device__ __forceinline__ f32x4 gelu4(f32x4 v) { const f32x2 a = gelu_pk((f32x2){v[0], v[1]}), b = gelu_pk((f32x2){v[2], v[3]}); return (f32x4){a.x, a.y, b.x, b.y}; }
__device__ __forceinline__ float dot4(f32x4 v) { return (v[0] * v[0] + v[1] * v[1]) + (v[2] * v[2] + v[3] * v[3]); }

struct EpiProj {
    static constexpr bool PERM = true, AFTER_DRAIN = false;
    bf16_t* dst5; bf16_t* dstg; const float* rope; const float* gate_b; const float* gnorm; float* gvss; float qscale;
    template <int KIND> __device__ __forceinline__ void body(const f32x4 (&acc)[2][2][4][2], const Unit& u, int seg, int wr, int wc, int fr, int fq) const {
        const int colt = (u.pn & 3) * BM;
        const int row0 = u.pm * BM + wr * 64 + fr, col0 = colt + wc * 32 + 8 * fq;
        bf16_t* base = (seg < 5) ? dst5 + (size_t)seg * ((size_t)32768 * 1024) : dstg + (size_t)(seg - 5) * ((size_t)32768 * 1024);
        const float sc = (seg == 0) ? qscale : 1.f;
        const bool rotw = (KIND == 0) && ((wc & 1) == 0);
        f32x4 cv[2][2];
        if (KIND == 3 || KIND == 4) { const float* p = (KIND == 3) ? gnorm : gate_b + (seg - 5) * 1024;
#pragma unroll
            for (int bj = 0; bj < 2; ++bj)
#pragma unroll
                for (int n = 0; n < 2; ++n) cv[bj][n] = *(const f32x4*)(p + col0 + bj * HALF + 4 * n); }
#pragma unroll
        for (int ai = 0; ai < 2; ++ai)
#pragma unroll
            for (int m = 0; m < 4; ++m) {
                const int row = row0 + ai * HALF + m * 16;
                f32x4 cs0, cs1, sn0, sn1;
                if (KIND == 0) { if (rotw) { const f32x4* rp = (const f32x4*)(rope + (size_t)row * 16); const f32x4 c0 = rp[0], c1 = rp[1], s0 = rp[2], s1 = rp[3];
                    const float sg = (fq == 0) ? -1.f : ((fq == 1) ? 1.f : 0.f); const bool rl = fq < 2;
                    cs0 = rl ? c0 : (f32x4){1.f, 1.f, 1.f, 1.f}; cs1 = rl ? c1 : (f32x4){1.f, 1.f, 1.f, 1.f}; sn0 = s0 * sg; sn1 = s1 * sg; } }
                float ss = 0.f;
                bf16_t* rowp = base + (size_t)row * 1024 + col0;
#pragma unroll
                for (int bj = 0; bj < 2; ++bj) {
                    f32x4 v0 = acc[ai][bj][m][0], v1 = acc[ai][bj][m][1];
                    if (KIND == 0) {
                        if (rotw) { f32x4 p0, p1;
#pragma unroll
                            for (int i = 0; i < 4; ++i) { p0[i] = __shfl_xor(v0[i], 16); p1[i] = __shfl_xor(v1[i], 16); }
                            v0 = v0 * cs0 + p0 * sn0; v1 = v1 * cs1 + p1 * sn1; }
                        v0 = v0 * sc; v1 = v1 * sc;
                    }
                    if (KIND == 2 || KIND == 3) { v0 = gelu4(v0); v1 = gelu4(v1); }
                    if (KIND == 3) { ss += dot4(v0) + dot4(v1); v0 = v0 * cv[bj][0]; v1 = v1 * cv[bj][1]; }
                    if (KIND == 4) { v0 = v0 + cv[bj][0]; v1 = v1 + cv[bj][1];
#pragma unroll
                        for (int i = 0; i < 4; ++i) { v0[i] = sigm(v0[i]); v1[i] = sigm(v1[i]); } }
                    u32x4 w; w.x = cvt_pk_bf16(v0[0], v0[1]); w.y = cvt_pk_bf16(v0[2], v0[3]); w.z = cvt_pk_bf16(v1[0], v1[1]); w.w = cvt_pk_bf16(v1[2], v1[3]);
                    *(u32x4*)(rowp + bj * HALF) = w;
                }
                if (KIND == 3) { ss += __shfl_xor(ss, 16); ss += __shfl_xor(ss, 32); if (fq == 0) __hip_atomic_store(gvss + (size_t)row * 16 + (u.pn & 3) * 4 + wc, ss, __ATOMIC_RELAXED, __HIP_MEMORY_SCOPE_AGENT); }
            }
    }
    __device__ __forceinline__ void operator()(const f32x4 (&acc)[2][2][4][2], const Unit& u, int wr, int wc, int fr, int fq) const {
        const int seg = u.pn >> 2;
#if EPI_PLAIN
        body<1>(acc, u, seg, wr, wc, fr, fq); return;
#endif
        if (seg <= 1) body<0>(acc, u, seg, wr, wc, fr, fq);
        else if (seg == 2) body<1>(acc, u, seg, wr, wc, fr, fq);
        else if (seg == 3) body<2>(acc, u, seg, wr, wc, fr, fq);
        else if (seg == 4) body<3>(acc, u, seg, wr, wc, fr, fq);
        else body<4>(acc, u, seg, wr, wc, fr, fq);
    }
};

struct EpiResid {
    static constexpr bool PERM = false, AFTER_DRAIN = false;
    const float* base; float* out; bf16_t* xb; float* ss;
    __device__ __forceinline__ void operator()(const f32x4 (&acc)[2][2][4][2], const Unit& u, int wr, int wc, int fr, int fq) const {
        typedef unsigned u32x2v __attribute__((ext_vector_type(2)));
        const int row0 = u.pm * BM + wr * 64 + fr, col0 = u.pn * BM + wc * 32 + 4 * fq;
#pragma unroll
        for (int ai = 0; ai < 2; ++ai)
#pragma unroll
            for (int m = 0; m < 4; ++m) {
                const int row = row0 + ai * HALF + m * 16; const size_t off = (size_t)row * 1024 + col0; float s = 0.f;
#pragma unroll
                for (int bj = 0; bj < 2; ++bj)
#pragma unroll
                    for (int n = 0; n < 2; ++n) {
                        const f32x4 bs = *(const f32x4*)(base + off + bj * HALF + n * 16); const f32x4 o = bs + acc[ai][bj][m][n];
                        *(f32x4*)(out + off + bj * HALF + n * 16) = o; s += dot4(o);
                        if (xb) { u32x2v w; w.x = cvt_pk_bf16(o[0], o[1]); w.y = cvt_pk_bf16(o[2], o[3]); *(u32x2v*)(xb + off + bj * HALF + n * 16) = w; }
                    }
                s += __shfl_xor(s, 16); s += __shfl_xor(s, 32);
                if (fq == 0) __hip_atomic_store(ss + (size_t)row * 16 + u.pn * 4 + wc, s, __ATOMIC_RELAXED, __HIP_MEMORY_SCOPE_AGENT);
                if (m & 1) asm volatile("" ::: "memory");
            }
    }
};

struct EpiSwiglu {
    static constexpr bool PERM = true, AFTER_DRAIN = false;
    bf16_t* act; const float* ss; int ldc;
    __device__ __forceinline__ void operator()(const f32x4 (&acc)[2][2][4][2], const Unit& u, int wr, int wc, int fr, int fq) const {
        const int row0 = u.pm * BM + wr * 64 + fr, col0 = u.pn * HALF + wc * 32 + 8 * fq;
#pragma unroll
        for (int ai = 0; ai < 2; ++ai)
#pragma unroll
            for (int m = 0; m < 4; ++m) {
                const int row = row0 + ai * HALF + m * 16;
                const f32x4* sp = (const f32x4*)(ss + (size_t)row * 16); const f32x4 t = (sp[0] + sp[1]) + (sp[2] + sp[3]);
                const float rinv = __builtin_amdgcn_rsqf(((t[0] + t[1]) + (t[2] + t[3])) * (1.0f / 1024.0f) + 1e-6f);
                f32x4 h[2];
#pragma unroll
                for (int n = 0; n < 2; ++n) { const f32x4 a = acc[ai][0][m][n] * rinv, b = acc[ai][1][m][n] * rinv;
#pragma unroll
                    for (int i = 0; i < 4; ++i) h[n][i] = a[i] * sigm(a[i]) * b[i]; }
                u32x4 w; w.x = cvt_pk_bf16(h[0][0], h[0][1]); w.y = cvt_pk_bf16(h[0][2], h[0][3]); w.z = cvt_pk_bf16(h[1][0], h[1][1]); w.w = cvt_pk_bf16(h[1][2], h[1][3]);
                *(u32x4*)(act + (size_t)row * ldc + col0) = w;
            }
    }
};

template <class Epi, class Sched, bool ALIGN_EPI = false, bool SP2 = false>
__device__ __forceinline__ void gemm_phase(PG8_LAS unsigned char* lds, const Gemm g, const Sched& S, const Epi& E) {
    const int tid = threadIdx.x, wid = __builtin_amdgcn_readfirstlane(tid >> 6), lane = tid & 63, wr = wid >> 2, wc = wid & 3, fr = lane & 15, fq = lane >> 4;
    const int K = g.K, nt = K / BK;
    unsigned voffA[2], voffB[2];
#pragma unroll
    for (int i = 0; i < 2; ++i) { int R, C; stage_rc(tid * 16 + i * 8192, R, C); const int Rb = Epi::PERM ? ((R & ~31) + perm32(R & 31)) : R;
        voffA[i] = (unsigned)(R * K + C) * 2u; voffB[i] = (unsigned)(Rb * K + C) * 2u; }
    const size_t kstep = (size_t)(BK * 2);
    const size_t hstep = (size_t)HALF * K * 2;
    const size_t tstep = 2 * hstep;
    const unsigned ldsw = (unsigned)wid * 1024u;
    const int aoff = lds_byte(wr * 64 + fr, fq * 8), boff = lds_byte(wc * 32 + fr, fq * 8);
#define PG8_SA(b, h) (((b) * 2 + (h)) * HTB)
#define PG8_SB(b, h) ((4 + (b) * 2 + (h)) * HTB)
#define PG8_STAGE(bufoff, gbase, voff) do { _Pragma("unroll") for (int _i = 0; _i < 2; ++_i) \
        __builtin_amdgcn_global_load_lds((const unsigned*)((const char*)(gbase) + (voff)[_i]), (PG8_LAS unsigned*)(lds + (bufoff) + ldsw + _i * 8192), 16, 0, 0); } while (0)
#define PG8_LDA(dst, b, h) do { _Pragma("unroll") for (int m = 0; m < 4; ++m) _Pragma("unroll") for (int k = 0; k < 2; ++k) dst[m][k] = *(const PG8_LAS bf16x8*)(lds + PG8_SA(b, h) + aoff + m * 2048 + k * 1024); } while (0)
#define PG8_LDB(dst, b, h) do { _Pragma("unroll") for (int n = 0; n < 2; ++n) _Pragma("unroll") for (int k = 0; k < 2; ++k) dst[n][k] = *(const PG8_LAS bf16x8*)(lds + PG8_SB(b, h) + boff + n * 2048 + k * 1024); } while (0)
#define PG8_MMA(ai, bj, At, Bt) do { __builtin_amdgcn_s_setprio(1); _Pragma("unroll") for (int m = 0; m < 4; ++m) _Pragma("unroll") for (int n = 0; n < 2; ++n) _Pragma("unroll") for (int k = 0; k < 2; ++k) \
        acc[ai][bj][m][n] = __builtin_amdgcn_mfma_f32_16x16x32_bf16(Bt[n][k], At[m][k], acc[ai][bj][m][n], 0, 0, 0); __builtin_amdgcn_s_setprio(0); } while (0)
#define PG8_WAIT_V(n) asm volatile("s_waitcnt vmcnt(" #n ")" ::: "memory")
#define PG8_WAIT_L(n) asm volatile("s_waitcnt lgkmcnt(" #n ")" ::: "memory")
#define PG8_BAR __builtin_amdgcn_s_barrier()
#define PG8_SCHED __builtin_amdgcn_sched_barrier(0)
    Unit cur, nxt; int ui = 0;
    if (!S.next(0, cur)) return;
    f32x4 acc[2][2][4][2];
#pragma unroll
    for (int a = 0; a < 2; ++a)
#pragma unroll
        for (int b = 0; b < 2; ++b)
#pragma unroll
            for (int m = 0; m < 4; ++m)
#pragma unroll
                for (int n = 0; n < 2; ++n) acc[a][b][m][n] = (f32x4){0.f, 0.f, 0.f, 0.f};
    bf16x8 At[4][2], B0[2][2], B1[2][2];
    const char* cA = (const char*)g.A + (size_t)cur.pm * tstep; const char* cB = (const char*)g.Bt + (size_t)cur.pn * tstep;
    S.a_ready(cur);
    if constexpr (SP2) {
        PG8_STAGE(PG8_SB(0, 0), cB, voffB); PG8_STAGE(PG8_SB(0, 1), cB + hstep, voffB); PG8_STAGE(PG8_SA(0, 0), cA, voffA); PG8_STAGE(PG8_SA(0, 1), cA + hstep, voffA);
        if (wr == 1) PG8_BAR;
        PG8_WAIT_V(2); PG8_BAR;
        PG8_STAGE(PG8_SB(1, 0), cB + kstep, voffB); PG8_STAGE(PG8_SA(1, 0), cA + kstep, voffA); PG8_STAGE(PG8_SB(1, 1), cB + hstep + kstep, voffB);
        PG8_WAIT_V(6); PG8_BAR;
    } else {
        PG8_STAGE(PG8_SB(0, 0), cB, voffB); PG8_STAGE(PG8_SA(0, 0), cA, voffA); PG8_STAGE(PG8_SB(0, 1), cB + hstep, voffB); PG8_STAGE(PG8_SA(0, 1), cA + hstep, voffA);
        if (wr == 1) PG8_BAR;
        PG8_WAIT_V(4); PG8_BAR;
        PG8_STAGE(PG8_SB(1, 0), cB + kstep, voffB); PG8_STAGE(PG8_SA(1, 0), cA + kstep, voffA); PG8_STAGE(PG8_SB(1, 1), cB + hstep + kstep, voffB);
        PG8_WAIT_V(6); PG8_BAR;
    }
    for (;;) {
        const bool has_next = S.next(ui + 1, nxt);
        const char* nA = has_next ? (const char*)g.A + (size_t)nxt.pm * tstep : cA; const char* nB = has_next ? (const char*)g.Bt + (size_t)nxt.pn * tstep : cB;
        for (int t = 0; t < nt; t += 2) {
            const bool last = (t == nt - 2);
            const char* a1 = cA + (size_t)(t + 1) * kstep;
            const char* a2 = last ? nA : cA + (size_t)(t + 2) * kstep; const char* b2 = last ? nB : cB + (size_t)(t + 2) * kstep;
            const char* a3 = a2 + kstep; const char* b3 = b2 + kstep;
            if (last && has_next) S.a_ready(nxt);
            if constexpr (SP2) {
            PG8_LDB(B0, 0, 0); PG8_LDB(B1, 0, 1); PG8_SCHED; PG8_LDA(At, 0, 0); PG8_STAGE(PG8_SA(1, 1), a1 + hstep, voffA);
            PG8_WAIT_V(8); PG8_WAIT_L(0); PG8_BAR; PG8_MMA(0, 0, At, B0); PG8_MMA(0, 1, At, B1); PG8_BAR; PG8_SCHED;
            PG8_LDA(At, 0, 1); PG8_STAGE(PG8_SB(0, 0), b2, voffB); PG8_STAGE(PG8_SB(0, 1), b2 + hstep, voffB); PG8_STAGE(PG8_SA(0, 0), a2, voffA);
            PG8_WAIT_V(8); PG8_WAIT_L(0); PG8_BAR; PG8_MMA(1, 0, At, B0); PG8_MMA(1, 1, At, B1); PG8_BAR; PG8_SCHED;
            PG8_LDB(B0, 1, 0); PG8_LDB(B1, 1, 1); PG8_SCHED; PG8_LDA(At, 1, 0); PG8_STAGE(PG8_SA(0, 1), a2 + hstep, voffA);
            PG8_WAIT_V(8); PG8_WAIT_L(0); PG8_BAR; PG8_MMA(0, 0, At, B0); PG8_MMA(0, 1, At, B1); PG8_BAR; PG8_SCHED;
            PG8_LDA(At, 1, 1); PG8_STAGE(PG8_SB(1, 0), b3, voffB); PG8_STAGE(PG8_SB(1, 1), b3 + hstep, voffB); PG8_STAGE(PG8_SA(1, 0), a3, voffA);
            PG8_WAIT_V(8); PG8_WAIT_L(0); PG8_BAR; PG8_MMA(1, 0, At, B0); PG8_MMA(1, 1, At, B1); PG8_BAR; PG8_SCHED;
            } else {
            PG8_LDB(B0, 0, 0); PG8_SCHED; PG8_LDA(At, 0, 0); PG8_STAGE(PG8_SA(1, 1), a1 + hstep, voffA);
            PG8_WAIT_L(8); PG8_BAR; PG8_WAIT_L(0); PG8_MMA(0, 0, At, B0); PG8_BAR; PG8_SCHED;
            PG8_LDB(B1, 0, 1); PG8_STAGE(PG8_SB(0, 0), b2, voffB);
            PG8_BAR; PG8_WAIT_L(0); PG8_MMA(0, 1, At, B1); PG8_BAR;
            PG8_LDA(At, 0, 1); PG8_STAGE(PG8_SA(0, 0), a2, voffA);
            PG8_BAR; PG8_WAIT_L(0); PG8_MMA(1, 0, At, B0); PG8_BAR; PG8_SCHED;
            PG8_STAGE(PG8_SB(0, 1), b2 + hstep, voffB);
            PG8_WAIT_V(6); PG8_BAR; PG8_MMA(1, 1, At, B1); PG8_BAR;
            PG8_LDB(B0, 1, 0); PG8_SCHED; PG8_LDA(At, 1, 0); PG8_STAGE(PG8_SA(0, 1), a2 + hstep, voffA);
            PG8_WAIT_L(8); PG8_BAR; PG8_WAIT_L(0); PG8_MMA(0, 0, At, B0); PG8_BAR; PG8_SCHED;
            PG8_LDB(B1, 1, 1); PG8_STAGE(PG8_SB(1, 0), b3, voffB);
            PG8_BAR; PG8_WAIT_L(0); PG8_MMA(0, 1, At, B1); PG8_BAR;
            PG8_LDA(At, 1, 1); PG8_STAGE(PG8_SA(1, 0), a3, voffA);
            PG8_BAR; PG8_WAIT_L(0); PG8_MMA(1, 0, At, B0); PG8_BAR; PG8_SCHED;
            PG8_STAGE(PG8_SB(1, 1), b3 + hstep, voffB);
            PG8_WAIT_V(6); PG8_BAR; PG8_MMA(1, 1, At, B1); PG8_BAR;
            }
        }
        if constexpr (ALIGN_EPI) { if (wr == 0) PG8_BAR; }
        if constexpr (!Epi::AFTER_DRAIN) { E(acc, cur, wr, wc, fr, fq); S.done(cur); }
        if (!has_next) break;
#pragma unroll
        for (int a = 0; a < 2; ++a)
#pragma unroll
            for (int b = 0; b < 2; ++b)
#pragma unroll
                for (int m = 0; m < 4; ++m)
#pragma unroll
                    for (int n = 0; n < 2; ++n) acc[a][b][m][n] = (f32x4){0.f, 0.f, 0.f, 0.f};
        cur = nxt; cA = nA; cB = nB; ++ui;
        if constexpr (ALIGN_EPI) { if (wr == 1) PG8_BAR; }
    }
    PG8_WAIT_V(0);
    if constexpr (!ALIGN_EPI) { if (wr == 0) PG8_BAR; }
    PG8_BAR;
    if constexpr (Epi::AFTER_DRAIN) { E.fused(acc, cur, wr, wc, fr, fq, lds, wid, lane); S.done(cur); }
#undef PG8_SA
#undef PG8_SB
#undef PG8_STAGE
#undef PG8_LDA
#undef PG8_LDB
#undef PG8_MMA
#undef PG8_WAIT_V
#undef PG8_WAIT_L
#undef PG8_BAR
#undef PG8_SCHED
}
}
namespace dattn {
#define DLAS __attribute__((address_space(3)))
typedef unsigned short bf16_t;
using bf16x8 = __attribute__((ext_vector_type(8))) short;
using s16x4 = __attribute__((ext_vector_type(4))) short;
using f32x16 = __attribute__((ext_vector_type(16))) float;
using f32x4 = __attribute__((ext_vector_type(4))) float;
using u32x4 = __attribute__((ext_vector_type(4))) unsigned;
typedef short v4i16_t __attribute__((ext_vector_type(4)));
constexpr int SEQ = 2048, DM = 1024, QB = 128, KVBLK = 64;
constexpr int SLOTB = 32768, OFF_K1 = 0, OFF_K2 = 8192, OFF_V = 16384;
constexpr float C2 = 0.125f * 1.4426950408889634f;
constexpr float THR = 8.0f;
__device__ __forceinline__ int crow(int r, int hi) { return (r & 3) + 8 * (r >> 2) + 4 * hi; }
__device__ __forceinline__ void glds16(const void* gsrc, unsigned lds_dst) { unsigned keep;
    asm volatile("s_mov_b32 %0, m0\n\ts_mov_b32 m0, %2\n\ts_nop 0\n\tglobal_load_lds_dwordx4 %1, off\n\ts_mov_b32 m0, %0" : "=&s"(keep) : "v"(gsrc), "s"(lds_dst) : "memory"); }
__device__ __forceinline__ s16x4 vtr(const DLAS unsigned char* p) { return __builtin_bit_cast(s16x4, __builtin_amdgcn_ds_read_tr16_b64_v4i16((DLAS v4i16_t*)p)); }
__device__ __forceinline__ float bf2f(unsigned short h) { return __uint_as_float((unsigned)h << 16); }
typedef float f32x2_t __attribute__((ext_vector_type(2))); typedef __bf16 bf16x2_t __attribute__((ext_vector_type(2)));
__device__ __forceinline__ unsigned cvtpk(float lo, float hi) { f32x2_t v = {lo, hi}; bf16x2_t b = __builtin_convertvector(v, bf16x2_t); return __builtin_bit_cast(unsigned, b); }
#define MX3(a, b, c) __builtin_fmaxf(__builtin_fmaxf((a), (b)), (c))
__device__ __forceinline__ float rowmax(const f32x16& p0, const f32x16& p1) {
    float a = MX3(p0[0], p0[1], p1[0]), b = MX3(p0[2], p0[3], p1[1]); a = MX3(a, p1[2], p1[3]);
#pragma unroll
    for (int r = 4; r < 16; r += 4) { a = MX3(a, p0[r], p0[r + 1]); b = MX3(b, p0[r + 2], p0[r + 3]); a = MX3(a, p1[r], p1[r + 1]); b = MX3(b, p1[r + 2], p1[r + 3]); }
    float m = __builtin_fmaxf(a, b); auto rr = __builtin_amdgcn_permlane32_swap(__float_as_uint(m), __float_as_uint(m), false, false);
    return __builtin_fmaxf(__uint_as_float(rr[0]), __uint_as_float(rr[1])); }
#define MFMA32(a, b, c) __builtin_amdgcn_mfma_f32_32x32x16_bf16(a, b, c, 0, 0, 0)
#define WAIT_BAR(N) asm volatile("s_waitcnt vmcnt(" #N ") lgkmcnt(0)\n\ts_barrier" ::: "memory")
#define BAR_ALL() asm volatile("s_waitcnt vmcnt(0) lgkmcnt(0)\n\ts_barrier" ::: "memory")

__device__ __forceinline__ void unit(int b, int h, int qb, const bf16_t* Q, const bf16_t* K, const bf16_t* V, const bf16_t* G0, const bf16_t* GM, bf16_t* MERGED,
                                     const float* subln_g, float lam, DLAS unsigned char* shm, DLAS float* wsf_base) {
    const int tid = threadIdx.x, lane = tid & 63, r32 = lane & 31, hi = lane >> 5; const int wid = __builtin_amdgcn_readfirstlane(tid >> 6);
    const int map = wid >> 2, rq = wid & 3;
    const long rowbase = (long)b * SEQ; const int q0 = qb * QB;
    const int NT = 2 * qb + 2, myNT = (rq < 2) ? NT - 1 : NT;
    const bf16_t* Qw = Q + (rowbase + q0 + rq * 32) * DM + h * 128 + map * 64;
    const bf16_t* Kh = K + rowbase * DM + h * 128; const bf16_t* Vh = V + rowbase * DM + h * 128;
    const unsigned lds0 = (unsigned)(uintptr_t)shm;
    DLAS float* wsf = wsf_base + wid * 64;
    const bf16_t* ksrc1 = Kh + (long)lane * DM + wid * 8; const bf16_t* ksrc2 = ksrc1 + 64;
    const bf16_t* vsrcA = Vh + (long)(16 * (wid & 3) + (lane >> 2)) * DM + (wid >> 2) * 32 + (lane & 3) * 8; const bf16_t* vsrcB = vsrcA + 64;
    const unsigned dK1 = lds0 + OFF_K1 + wid * 1024, dK2 = lds0 + OFF_K2 + wid * 1024, dVA = lds0 + OFF_V + wid * 1024, dVB = lds0 + OFF_V + (wid + 8) * 1024;
#define RFL(x) ((unsigned)__builtin_amdgcn_readfirstlane(x))
#define DMA_T(t, slot) do { const long go_ = (long)(t) * KVBLK * DM; glds16(ksrc1 + go_, RFL(dK1 + (slot))); glds16(ksrc2 + go_, RFL(dK2 + (slot))); glds16(vsrcA + go_, RFL(dVA + (slot))); glds16(vsrcB + go_, RFL(dVB + (slot))); } while (0)
    const DLAS unsigned char* kp0 = shm + (map ? OFF_K2 : OFF_K1) + hi * 1024 + r32 * 16;
    const DLAS unsigned char* vp0 = shm + OFF_V + ((lane >> 4) & 1) * 32 + (lane & 3) * 8 + (4 * hi + ((lane & 15) >> 2)) * 64;
    bf16x8 qr[4];
#pragma unroll
    for (int d0 = 0; d0 < 4; ++d0) qr[d0] = *reinterpret_cast<const bf16x8*>(Qw + (long)r32 * DM + d0 * 16 + hi * 8);
    DMA_T(0, 0); DMA_T(1, SLOTB);
    float mref = 0.f, l_reg = 0.f; f32x16 o[4]; o[0] = f32x16{}; o[1] = f32x16{}; o[2] = f32x16{}; o[3] = f32x16{};
    f32x16 negm = f32x16{};
    int sl_cur = 0, sl_nn = 2 * SLOTB;
    for (int t = 0; t < NT; ++t) {
        if (t + 1 < NT) { WAIT_BAR(4); } else { WAIT_BAR(0); }
        if (t + 2 < NT) DMA_T(t + 2, sl_nn);
        if (t < myNT) {
            const DLAS unsigned char* kp = kp0 + sl_cur; const DLAS unsigned char* vp = vp0 + sl_cur;
            f32x16 p0 = negm, p1 = negm;
#pragma unroll
            for (int d0 = 0; d0 < 4; ++d0) {
                const bf16x8 k0 = *(const DLAS bf16x8*)(kp + d0 * 2048), k1 = *(const DLAS bf16x8*)(kp + d0 * 2048 + 512);
                p0 = MFMA32(k0, qr[d0], p0); p1 = MFMA32(k1, qr[d0], p1);
            }
            const float rm = rowmax(p0, p1);
            if (t == 0 || __any(rm > THR)) {
                const float dl = (t == 0) ? rm : __builtin_fmaxf(rm, 0.f);
                mref += dl;
#pragma unroll
                for (int r = 0; r < 16; ++r) { p0[r] -= dl; p1[r] -= dl; }
#pragma unroll
                for (int r = 0; r < 16; ++r) negm[r] = -mref;
                if (t != 0) {
                    const float f = __builtin_amdgcn_exp2f(-dl); l_reg *= f;
                    if (hi == 0) wsf[r32] = f;
                    asm volatile("s_waitcnt lgkmcnt(0)" ::: "memory");
                    float a[16];
#pragma unroll
                    for (int r = 0; r < 16; ++r) a[r] = wsf[crow(r, hi)];
#pragma unroll
                    for (int d = 0; d < 4; ++d)
#pragma unroll
                        for (int r = 0; r < 16; ++r) o[d][r] *= a[r];
                }
            }
            float sacc = 0.f;
#pragma unroll
            for (int r = 0; r < 16; ++r) { p0[r] = __builtin_amdgcn_exp2f(p0[r]); p1[r] = __builtin_amdgcn_exp2f(p1[r]); sacc += p0[r] + p1[r]; }
            l_reg += sacc;
            u32x4 pw[4];
            pw[0] = (u32x4){cvtpk(p0[0], p0[1]), cvtpk(p0[2], p0[3]), cvtpk(p0[4], p0[5]), cvtpk(p0[6], p0[7])};
            pw[1] = (u32x4){cvtpk(p0[8], p0[9]), cvtpk(p0[10], p0[11]), cvtpk(p0[12], p0[13]), cvtpk(p0[14], p0[15])};
            pw[2] = (u32x4){cvtpk(p1[0], p1[1]), cvtpk(p1[2], p1[3]), cvtpk(p1[4], p1[5]), cvtpk(p1[6], p1[7])};
            pw[3] = (u32x4){cvtpk(p1[8], p1[9]), cvtpk(p1[10], p1[11]), cvtpk(p1[12], p1[13]), cvtpk(p1[14], p1[15])};
#pragma unroll
            for (int dq = 0; dq < 4; ++dq) {
#pragma unroll
                for (int ks = 0; ks < 4; ++ks) {
                    const s16x4 lo = vtr(vp + dq * 4096 + ks * 1024), hh = vtr(vp + dq * 4096 + ks * 1024 + 512);
                    const bf16x8 vf = (bf16x8){lo[0], lo[1], lo[2], lo[3], hh[0], hh[1], hh[2], hh[3]};
                    o[dq] = MFMA32(__builtin_bit_cast(bf16x8, pw[ks]), vf, o[dq]);
                }
            }
        }
        sl_cur = (sl_cur == 2 * SLOTB) ? 0 : sl_cur + SLOTB; sl_nn = (sl_nn == 2 * SLOTB) ? 0 : sl_nn + SLOTB;
    }
    { auto rr = __builtin_amdgcn_permlane32_swap(__float_as_uint(l_reg), __float_as_uint(l_reg), false, false); l_reg = __uint_as_float(rr[0]) + __uint_as_float(rr[1]); }
    if (hi == 0) wsf[32 + r32] = l_reg;
    asm volatile("s_waitcnt lgkmcnt(0)" ::: "memory");
    float rli[16];
#pragma unroll
    for (int r = 0; r < 16; ++r) rli[r] = __builtin_amdgcn_rcpf(wsf[32 + crow(r, hi)]);
    BAR_ALL();
    DLAS float* st = (DLAS float*)shm;
#pragma unroll
    for (int r = 0; r < 16; ++r) { const int row = map * 128 + rq * 32 + crow(r, hi);
#pragma unroll
        for (int dq = 0; dq < 4; ++dq) st[row * 128 + dq * 32 + r32] = o[dq][r] * rli[r]; }
    BAR_ALL();
#pragma unroll
    for (int ps = 0; ps < 4; ++ps) {
        const int item = ps * 512 + tid, row = item >> 4, ch = item & 15;
        const DLAS f32x4* p1 = (const DLAS f32x4*)(st + row * 128 + ch * 8); const DLAS f32x4* p2 = (const DLAS f32x4*)(st + 16384 + row * 128 + ch * 8);
        const f32x4 o0 = p1[0] - p2[0] * lam, o1 = p1[1] - p2[1] * lam;
        float ss = ((o0[0] * o0[0] + o0[1] * o0[1]) + (o0[2] * o0[2] + o0[3] * o0[3])) + ((o1[0] * o1[0] + o1[1] * o1[1]) + (o1[2] * o1[2] + o1[3] * o1[3]));
        ss += __shfl_xor(ss, 1); ss += __shfl_xor(ss, 2); ss += __shfl_xor(ss, 4); ss += __shfl_xor(ss, 8);
        const float rinv = __builtin_amdgcn_rsqf(ss * (1.0f / 128.0f) + 1e-5f) * 0.8f;
        const size_t gi = (size_t)(rowbase + q0 + row) * DM + h * 128 + ch * 8;
        const u32x4 g0v = *(const u32x4*)(G0 + gi), gmv = *(const u32x4*)(GM + gi);
        const f32x4 sg0 = *(const f32x4*)(subln_g + ch * 8), sg1 = *(const f32x4*)(subln_g + ch * 8 + 4);
        float y[8];
#pragma unroll
        for (int i = 0; i < 4; ++i) { y[i] = o0[i] * rinv * sg0[i]; y[4 + i] = o1[i] * rinv * sg1[i]; }
        u32x4 w;
#pragma unroll
        for (int i = 0; i < 4; ++i) {
            const unsigned gg = g0v[i], mm = gmv[i];
            const float lo = __uint_as_float(gg << 16) * y[2 * i] + __uint_as_float(mm << 16), hh = __uint_as_float(gg & 0xffff0000u) * y[2 * i + 1] + __uint_as_float(mm & 0xffff0000u);
            w[i] = cvtpk(lo, hh);
        }
        *(u32x4*)(MERGED + gi) = w;
    }
    BAR_ALL();
#undef DMA_T
#undef RFL
}

constexpr int GST = 132;
__device__ __forceinline__ void gmlp_unit(int b, int n, int g, const bf16_t* GV, const bf16_t* GU, const bf16_t* G1, const float* gvss, const bf16_t* Wp, const float* bs, bf16_t* GM,
                                          DLAS unsigned char* shm) {
    const int tid = threadIdx.x, lane = tid & 63, r32 = lane & 31, hi = lane >> 5; const int wid = __builtin_amdgcn_readfirstlane(tid >> 6);
    const long rowbase = (long)b * SEQ + n * 128;
    DLAS float* rin = (DLAS float*)(shm + 32768);
    DLAS float* st = (DLAS float*)(shm + 36864);
    u32x4 guv[4], g1v[4];
#pragma unroll
    for (int it = 0; it < 4; ++it) { const int item = it * 512 + tid, row = item >> 4, c16 = item & 15; const size_t gi = (size_t)(rowbase + row) * DM + g * 128 + c16 * 8;
        guv[it] = *(const u32x4*)(GU + gi); g1v[it] = *(const u32x4*)(G1 + gi); }
    if (tid < 128) { const f32x4* sp = (const f32x4*)(gvss + (size_t)(rowbase + tid) * 16); const f32x4 t = (sp[0] + sp[1]) + (sp[2] + sp[3]);
        rin[tid] = __builtin_amdgcn_rsqf(((t[0] + t[1]) + (t[2] + t[3])) * (1.0f / 1024.0f) + 1e-6f); }
    u32x4 vv[4];
#pragma unroll
    for (int it = 0; it < 4; ++it) { const int item = it * 512 + tid, row = item >> 4, c16 = item & 15; vv[it] = *(const u32x4*)(GV + (size_t)(rowbase + row) * DM + g * 128 + c16 * 8); }
    __syncthreads();
#pragma unroll
    for (int it = 0; it < 4; ++it) {
        const int item = it * 512 + tid, row = item >> 4, c16 = item & 15; const float ri = rin[row]; const u32x4 v = vv[it];
        u32x4 w;
#pragma unroll
        for (int i = 0; i < 4; ++i) w[i] = cvtpk(__uint_as_float(v[i] << 16) * ri, __uint_as_float(v[i] & 0xffff0000u) * ri);
        *(DLAS u32x4*)(shm + (c16 >> 2) * 8192 + row * 64 + (c16 & 3) * 16) = w;
    }
    __syncthreads();
    const int ib = wid >> 1, cb0 = 2 * (wid & 1), nks = (ib < 2) ? 4 : 8;
    const DLAS unsigned char* vp0 = shm + ((lane >> 4) & 1) * 32 + (lane & 3) * 8 + (4 * hi + ((lane & 15) >> 2)) * 64;
    const bf16_t* wrow = Wp + ((size_t)(g * 128 + ib * 32 + r32)) * 128 + hi * 8;
    f32x16 acc[2]; acc[0] = f32x16{}; acc[1] = f32x16{};
    for (int ks = 0; ks < nks; ++ks) {
        const bf16x8 a = *(const bf16x8*)(wrow + ks * 16);
#pragma unroll
        for (int c = 0; c < 2; ++c) {
            const s16x4 lo = vtr(vp0 + (cb0 + c) * 8192 + ks * 1024), hh = vtr(vp0 + (cb0 + c) * 8192 + ks * 1024 + 512);
            const bf16x8 vf = (bf16x8){lo[0], lo[1], lo[2], lo[3], hh[0], hh[1], hh[2], hh[3]};
            acc[c] = MFMA32(a, vf, acc[c]);
        }
    }
#pragma unroll
    for (int r = 0; r < 16; ++r) { const int i = ib * 32 + crow(r, hi); const float bb = bs[g * 128 + i];
#pragma unroll
        for (int c = 0; c < 2; ++c) st[i * GST + (cb0 + c) * 32 + r32] = acc[c][r] + bb; }
    __syncthreads();
#pragma unroll
    for (int it = 0; it < 4; ++it) {
        const int item = it * 512 + tid, row = item >> 4, c16 = item & 15;
        const DLAS f32x4* sp = (const DLAS f32x4*)(st + row * GST + c16 * 8); const f32x4 m0 = sp[0], m1 = sp[1];
        const u32x4 u = guv[it], q = g1v[it]; u32x4 w;
#pragma unroll
        for (int i = 0; i < 4; ++i) { const float ml = (i < 2) ? m0[2 * i] : m1[2 * i - 4], mh = (i < 2) ? m0[2 * i + 1] : m1[2 * i - 3];
            w[i] = cvtpk(__uint_as_float(u[i] << 16) * ml * __uint_as_float(q[i] << 16), __uint_as_float(u[i] & 0xffff0000u) * mh * __uint_as_float(q[i] & 0xffff0000u)); }
        *(u32x4*)(GM + (size_t)(rowbase + row) * DM + g * 128 + c16 * 8) = w;
    }
    __syncthreads();
}
#undef MX3
#undef MFMA32
#undef WAIT_BAR
#undef BAR_ALL
}

#ifndef REP_P0
#define REP_P0 1
#endif
#ifndef REP_P2A
#define REP_P2A 1
#endif
#ifndef REP_G4
#define REP_G4 1
#endif
#ifndef REP_ATTN
#define REP_ATTN 1
#endif
#ifndef REP_G1
#define REP_G1 1
#endif
#ifndef STOP_AFTER
#define STOP_AFTER 0
#endif
constexpr int NWAVES = 8;
constexpr int M = 16 * 2048, D = 1024, DIN = 7168, DFF = 2816;
constexpr size_t MiB = 1u << 20;
constexpr size_t WS_CTL = 0, CTL_ZERO_BYTES = 1 * MiB;
constexpr size_t WS_WIN = 2 * MiB, WS_WOUT = 16 * MiB, WS_WFFI = 18 * MiB, WS_WFFO = 29 * MiB, WS_WSP = 35 * MiB, WS_ROPE = 36 * MiB;
constexpr size_t WS_SS0 = 38 * MiB, WS_SS1 = 40 * MiB, WS_SS2 = 42 * MiB;
constexpr size_t WS_XN = 48 * MiB, WS_Q = 112 * MiB, WS_K = 176 * MiB, WS_V = 240 * MiB, WS_GU = 304 * MiB, WS_GV = 368 * MiB, WS_END = 432 * MiB;
static_assert(WS_WFFO + (size_t)D * DFF * 2 <= WS_WSP && WS_K + (size_t)M * DFF * 2 <= WS_GV, "d_ws map");
constexpr int CW_BAR = 4096;
constexpr int RING_OFF = 0, RING_BYTES = 131072;
constexpr int LDSCTL_OFF = RING_BYTES, MISC_OFF = LDSCTL_OFF + 320, WSF_OFF = LDSCTL_OFF + 4096;
constexpr int LDS_BYTES = 147456;
#define GAS __attribute__((address_space(1)))
#define LAS __attribute__((address_space(3)))
typedef unsigned short bf16;
typedef unsigned v4u __attribute__((ext_vector_type(4)));
typedef float f32x4 __attribute__((ext_vector_type(4)));
typedef short bf16x8 __attribute__((ext_vector_type(8)));
typedef GAS unsigned gu32;
typedef GAS unsigned long long gu64;
#define RLX_AGENT __ATOMIC_RELAXED, __HIP_MEMORY_SCOPE_AGENT
#define LDS_WAIT() asm volatile("s_waitcnt lgkmcnt(0)" ::: "memory")
#define VM_WAIT() asm volatile("s_waitcnt vmcnt(0)" ::: "memory")
__device__ __forceinline__ unsigned long long rt() { return __builtin_amdgcn_s_memrealtime(); }
__device__ __forceinline__ unsigned f2bf(float f) { unsigned u = __builtin_bit_cast(unsigned, f); return (u + 0x7fffu + ((u >> 16) & 1u)) >> 16; }
__device__ __forceinline__ unsigned pk2(float lo, float hi) { return f2bf(lo) | (f2bf(hi) << 16); }

#define XB_TMO      128
#define XB_XCNT(j)  (256  + 64 * (j))
#define XB_XSUB(j)  (1280 + 64 * (j))
#define XB_XGEN(j)  (2304 + 64 * (j))
#define XB_TOP      3328
#define XB_TOPGEN   3392
#define XCD_BAR_WORDS 3456
#define XB_SPIN_CAP (1u << 18)

__device__ __forceinline__ unsigned xb_ld(unsigned* p)              { return __hip_atomic_load(p, __ATOMIC_RELAXED, __HIP_MEMORY_SCOPE_AGENT); }
__device__ __forceinline__ unsigned xb_add(unsigned* p, unsigned v) { return __hip_atomic_fetch_add(p, v, __ATOMIC_RELAXED, __HIP_MEMORY_SCOPE_AGENT); }
__device__ __forceinline__ unsigned xb_xcc_id() { return (unsigned)__builtin_amdgcn_s_getreg((3 << 11) | 20) & 0xFu; }
#define XB_SPIN(cond, bar) do { unsigned _sp = 0; while (cond) { __builtin_amdgcn_s_sleep(1); \
    if ((++_sp & 255u) == 0u) { if (xb_ld(&(bar)[XB_TMO])) break; if (_sp > XB_SPIN_CAP) { atomicAdd(&(bar)[XB_TMO], 1u); break; } } } } while (0)

struct XcdBarrier {
    unsigned* bar; unsigned x;
    volatile LAS unsigned* st;
};

__device__ __forceinline__ XcdBarrier xcd_barrier_post(unsigned* bar, volatile LAS unsigned* st) {
    XcdBarrier b; b.bar = bar; b.x = xb_xcc_id(); b.st = st;
    if (threadIdx.x == 0) (void)xb_add(&bar[XB_XCNT(b.x)], 1u);
    return b;
}
__device__ __forceinline__ void xcd_barrier_complete(unsigned* bar, unsigned x, unsigned& nloc, unsigned& nx) {
    const unsigned G = gridDim.x * gridDim.y * gridDim.z;
    unsigned sum, cnt, mine, sp = 0u;
    for (;;) {
        sum = 0u; cnt = 0u; mine = 0u;
#pragma unroll
        for (unsigned j = 0; j < 16; ++j) { const unsigned c = xb_ld(&bar[XB_XCNT(j)]); sum += c; cnt += (c > 0u) ? 1u : 0u; mine = (j == x) ? c : mine; }
        if (sum == G) break;
        __builtin_amdgcn_s_sleep(1);
        if ((++sp & 255u) == 0u) { if (xb_ld(&bar[XB_TMO])) break; if (sp > XB_SPIN_CAP) { atomicAdd(&bar[XB_TMO], 1u); break; } }
    }
    nloc = mine > 0u ? mine : 1u; nx = cnt > 0u ? cnt : 1u;
}

__device__ __forceinline__ void xcd_barrier(const XcdBarrier& b) {
    asm volatile("s_waitcnt vmcnt(0)" ::: "memory");
    __syncthreads();
    if (threadIdx.x == 0) {
        unsigned* bar = b.bar;
        __builtin_amdgcn_s_waitcnt(0);
        unsigned nloc = b.st[0], nx = b.st[1];
        if (nloc == 0u) { xcd_barrier_complete(bar, b.x, nloc, nx); b.st[0] = nloc; b.st[1] = nx; }
        const unsigned old = xb_add(&bar[XB_XSUB(b.x)], 1u);
        const unsigned gen = old / nloc;
        if (old + 1u == (gen + 1u) * nloc) {
            __builtin_amdgcn_fence(__ATOMIC_RELEASE, "agent");
            asm volatile("s_waitcnt vmcnt(0)" ::: "memory");
            const unsigned og = xb_add(&bar[XB_TOP], 1u);
            const unsigned tg = og / nx;
            if (og + 1u == (tg + 1u) * nx) xb_add(&bar[XB_TOPGEN], 1u);
            else XB_SPIN(xb_ld(&bar[XB_TOPGEN]) == tg, bar);
            __builtin_amdgcn_fence(__ATOMIC_ACQUIRE, "agent");
            xb_add(&bar[XB_XGEN(b.x)], 1u);
            asm volatile("s_waitcnt vmcnt(0)" ::: "memory");
        } else {
            XB_SPIN(xb_ld(&bar[XB_XGEN(b.x)]) == gen, bar);
            __builtin_amdgcn_fence(__ATOMIC_ACQUIRE, "agent");
            asm volatile("s_waitcnt vmcnt(0)" ::: "memory");
        }
    }
    __syncthreads();
}
struct Frame {
    LAS unsigned char* lds;
    volatile LAS unsigned* MISC;
    gu32* ctl;
    int tid, lane, wave;
    int vcu, G;
};

__device__ __forceinline__ float wave_sum(float v) {
#pragma unroll
    for (int o = 1; o < 64; o <<= 1) v += __shfl_xor(v, o);
    return v;
}
__device__ __forceinline__ void p0_transpose_item(const float* W, int K, int N, bf16* WT, int n0d, int n0s, int k0, const float* kscale, LAS float* scr, int lane) {
#pragma unroll 8
    for (int i = 0; i < 32; ++i) { const int kk = 2 * i + (lane >> 5); float v = W[(size_t)(k0 + kk) * N + n0s + (lane & 31)]; if (kscale) v *= kscale[k0 + kk]; scr[kk * 33 + (lane & 31)] = v; }
    LDS_WAIT(); asm volatile("" ::: "memory");
    const int c = lane & 7;
#pragma unroll
    for (int j = 0; j < 4; ++j) { const int n = (lane >> 3) + 8 * j; const LAS float* s = scr + (8 * c) * 33 + n;
        v4u o; o.x = pk2(s[0 * 33], s[1 * 33]); o.y = pk2(s[2 * 33], s[3 * 33]); o.z = pk2(s[4 * 33], s[5 * 33]); o.w = pk2(s[6 * 33], s[7 * 33]);
        *(GAS v4u*)(WT + (size_t)(n0d + n) * K + k0 + 8 * c) = o; }
    LDS_WAIT(); asm volatile("" ::: "memory");
}

struct Args { const float* in[15]; float* out; unsigned char* ws; };

__global__ void __launch_bounds__(NWAVES * 64, 2) skel_fwd(Args args) {
    extern __shared__ __attribute__((aligned(16))) unsigned char lds[];
    Frame F;
    F.lds = (LAS unsigned char*)lds;
    F.MISC = (volatile LAS unsigned*)(F.lds + MISC_OFF);
    F.tid = threadIdx.x; F.lane = F.tid & 63; F.wave = __builtin_amdgcn_readfirstlane(F.tid >> 6);
    F.G = gridDim.x; { const int bx = blockIdx.x; F.vcu = (F.G % 8 == 0) ? (bx % 8) * (F.G / 8) + bx / 8 : bx; }
    unsigned char* ws = args.ws;
    F.ctl = (gu32*)(ws + WS_CTL);
    const float* x = args.in[0]; const int* positions = (const int*)args.in[1]; const float* norm_mix_g = args.in[2]; const float* w_in = args.in[3];
    const float* gate_b = args.in[4]; const float* lambdas = args.in[5]; const float* subln_g = args.in[6]; const float* gm_norm_g = args.in[7];
    const float* gm_ws = args.in[8]; const float* gm_bs = args.in[9]; const float* w_out = args.in[10]; const float* norm_ffn_g = args.in[11];
    const float* w_ffn_in = args.in[12]; const float* w_ffn_out = args.in[13]; const float* norm_final_g = args.in[14];
    float* out = args.out;
    bf16* Win_t = (bf16*)(ws + WS_WIN); bf16* Wout_t = (bf16*)(ws + WS_WOUT); bf16* Wffi_t = (bf16*)(ws + WS_WFFI); bf16* Wffo_t = (bf16*)(ws + WS_WFFO);
    bf16* Wsp = (bf16*)(ws + WS_WSP); float* rope = (float*)(ws + WS_ROPE);
    float* gvss = (float*)(ws + WS_SS0); float* x1ss = (float*)(ws + WS_SS1); float* x2ss = (float*)(ws + WS_SS2);
    bf16* XN = (bf16*)(ws + WS_XN); bf16* GMB = (bf16*)(ws + WS_XN);
    bf16* QB_ = (bf16*)(ws + WS_Q); bf16* KB = (bf16*)(ws + WS_K); bf16* VB = (bf16*)(ws + WS_V); bf16* GU = (bf16*)(ws + WS_GU); bf16* GV = (bf16*)(ws + WS_GV);
    bf16* MERGED = (bf16*)(ws + WS_GU);
    bf16* G0 = (bf16*)out; bf16* G1 = (bf16*)out + (size_t)M * D;
    bf16* X1B = (bf16*)(ws + WS_Q);
    bf16* ACT = (bf16*)(ws + WS_K);

    for (int u = F.tid; u < (LDS_BYTES - LDSCTL_OFF) / 4; u += NWAVES * 64) ((LAS unsigned*)(F.lds + LDSCTL_OFF))[u] = 0u;
    __syncthreads();
    XcdBarrier bar = xcd_barrier_post((unsigned*)(F.ctl + CW_BAR), F.MISC + 8);
    const int gw = F.vcu * NWAVES + F.wave, NGW = F.G * NWAVES;

    for (int rep0 = 0; rep0 < REP_P0; ++rep0) {
        LAS float* scr = (LAS float*)(F.lds + RING_OFF + F.wave * 16384);
        constexpr int I_IN = (D / 64) * (DIN / 32), I_OUT = (D / 64) * (D / 32), I_FFI = (D / 64) * (2 * DFF / 32), I_FFO = (DFF / 64) * (D / 32);
        constexpr int NITEMS = I_IN + I_OUT + I_FFI + I_FFO;
        for (int it = gw; it < NITEMS; it += NGW) {
            int r = it;
            if (r < I_IN) { const int nblk = DIN / 32, kb = r / nblk, nb = r % nblk; p0_transpose_item(w_in, D, DIN, Win_t, 32 * nb, 32 * nb, 64 * kb, nullptr, scr, F.lane); continue; } r -= I_IN;
            if (r < I_OUT) { const int nblk = D / 32, kb = r / nblk, nb = r % nblk; p0_transpose_item(w_out, D, D, Wout_t, 32 * nb, 32 * nb, 64 * kb, nullptr, scr, F.lane); continue; } r -= I_OUT;
            if (r < I_FFI) { const int nblk = 2 * DFF / 32, kb = r / nblk, nb = r % nblk; const int n0d = 32 * nb, j = n0d >> 8, c = n0d & 255;
                const int n0s = (c < 128) ? 128 * j + c : DFF + 128 * j + (c - 128);
                p0_transpose_item(w_ffn_in, D, 2 * DFF, Wffi_t, n0d, n0s, 64 * kb, norm_ffn_g, scr, F.lane); continue; } r -= I_FFI;
            { const int nblk = D / 32, kb = r / nblk, nb = r % nblk; p0_transpose_item(w_ffn_out, DFF, D, Wffo_t, 32 * nb, 32 * nb, 64 * kb, nullptr, scr, F.lane); }
        }
        for (int e = (int)blockIdx.x * (NWAVES * 64) + F.tid; e < 8 * 128 * 128; e += F.G * NWAVES * 64) {
            const int jp = e & 127, i = (e >> 7) & 127, g = e >> 14; const int ks = jp >> 4, hh = (jp >> 3) & 1, jj = jp & 7; const int j = 16 * ks + 8 * (jj >> 2) + 4 * hh + (jj & 3);
            const float v = ((j >> 6) <= (i >> 6)) ? gm_ws[(size_t)(g * 128 + i) * 128 + j] : 0.f;
            Wsp[e] = (bf16)f2bf(v);
        }
        for (int e = (int)blockIdx.x * (NWAVES * 64) + F.tid; e < M * 8; e += F.G * NWAVES * 64) {
            const int m = e >> 3, i = e & 7;
            const float fr = (i == 0) ? 1.0f : (i == 1) ? 0.1939227432012558f : (i == 2) ? 0.03760603070259094f : (i == 3) ? 0.007292664609849453f : (i == 4) ? 0.0014142135623842478f
                           : (i == 5) ? 0.00027424818836152554f : (i == 6) ? 5.318296098266728e-05f : 1.0313386155758053e-05f;
            const float ang = (float)positions[m] * fr;
            const double tt = (double)ang * 0.15915494309189535; const float tf = (float)(tt - __builtin_rint(tt));
            rope[(size_t)m * 16 + i] = __builtin_amdgcn_cosf(tf); rope[(size_t)m * 16 + 8 + i] = __builtin_amdgcn_sinf(tf);
        }
        for (int m = gw; m < M; m += NGW) {
            const GAS f32x4* xr = (const GAS f32x4*)(x + (size_t)m * D) + F.lane; f32x4 v[4]; float s = 0.f;
#pragma unroll
            for (int j = 0; j < 4; ++j) { v[j] = xr[64 * j]; s += (v[j].x * v[j].x + v[j].y * v[j].y) + (v[j].z * v[j].z + v[j].w * v[j].w); }
            const float rinv = __builtin_amdgcn_rsqf(wave_sum(s) * (1.f / D) + 1e-6f);
            GAS unsigned long long* o8 = (GAS unsigned long long*)(XN + (size_t)m * D) + F.lane;
#pragma unroll
            for (int j = 0; j < 4; ++j) { const f32x4 gg = *((const f32x4*)norm_mix_g + F.lane + 64 * j);
                o8[64 * j] = (unsigned long long)pk2(v[j].x * rinv * gg.x, v[j].y * rinv * gg.y) | ((unsigned long long)pk2(v[j].z * rinv * gg.z, v[j].w * rinv * gg.w) << 32); }
        }
    }
    xcd_barrier(bar);

#if STOP_AFTER == 10
    { const size_t n = (size_t)M * D; for (size_t i = (size_t)blockIdx.x * 512 + F.tid; i < n; i += (size_t)F.G * 512)
        out[i] = pg8::bf2f(XN[i]) + pg8::bf2f(Win_t[i % ((size_t)DIN * D)]) + pg8::bf2f(Wffi_t[i % ((size_t)2 * DFF * D)]) + pg8::bf2f(Wffo_t[i % ((size_t)DFF * D)]) + pg8::bf2f(Wout_t[i % ((size_t)D * D)]) + rope[i % ((size_t)M * 16)] + pg8::bf2f(Wsp[i % 131072]); }
    return;
#endif
    {
        pg8::Gemm g{XN, Win_t, M, DIN, D}; pg8::StaticOrder S; S.init(M, DIN, F.G, (int)blockIdx.x);
        pg8::EpiProj E; E.dst5 = QB_; E.dstg = G0;
        E.rope = rope; E.gate_b = gate_b; E.gnorm = gm_norm_g; E.gvss = gvss; E.qscale = dattn::C2;
        pg8::gemm_phase<pg8::EpiProj, pg8::StaticOrder, true, true>(F.lds + RING_OFF, g, S, E);
#if REP_G1 == 2
        pg8::gemm_phase<pg8::EpiProj, pg8::StaticOrder, true, true>(F.lds + RING_OFF, g, S, E);
#endif
    }
    xcd_barrier(bar);
#if STOP_AFTER == 1
    { const size_t n = (size_t)M * D; const unsigned* gp = (const unsigned*)out;
      for (size_t i = (size_t)blockIdx.x * 512 + F.tid; i < n; i += (size_t)F.G * 512) { const unsigned g2 = gp[i];
        out[i] = __uint_as_float(g2 << 16) + __uint_as_float(g2 & 0xffff0000u) + pg8::bf2f(QB_[i]) + pg8::bf2f(KB[i]) + pg8::bf2f(VB[i]) + pg8::bf2f(GU[i]) + pg8::bf2f(GV[i]) + gvss[i & ((size_t)M * 16 - 1)] * 0.001f; } }
    return;
#endif

    {
        const int per = (2048 + F.G - 1) / F.G;
        for (int rep = 0; rep < REP_P2A; ++rep)
        for (int i = 0; i < per; ++i) { const int id = F.vcu * per + i; if (id < 2048) dattn::gmlp_unit(id >> 7, (id >> 3) & 15, id & 7, GV, GU, G1, gvss, Wsp, gm_bs, GMB, F.lds + RING_OFF); }
    }
    xcd_barrier(bar);
#if STOP_AFTER == 2
    { const size_t n = (size_t)M * D; for (size_t i = (size_t)blockIdx.x * 512 + F.tid; i < n; i += (size_t)F.G * 512) out[i] = pg8::bf2f(GMB[i]); }
    return;
#endif

    {
        const float a = lambdas[F.lane] * lambdas[64 + F.lane], c = lambdas[128 + F.lane] * lambdas[192 + F.lane];
        const float lam = __expf(wave_sum(a)) - __expf(wave_sum(c)) + 0.2f;
        const int per = (1024 + F.G - 1) / F.G;
        for (int rep = 0; rep < REP_ATTN; ++rep)
        for (int j = 0; j < per; ++j) { const int pr = F.vcu * per + j; if (pr >= 1024) break; const int bh = pr >> 3, s = pr & 7;
            for (int k = 0; k < 2; ++k) dattn::unit(bh >> 3, bh & 7, k ? 15 - s : s, QB_, KB, VB, G0, GMB, MERGED, subln_g, lam, F.lds + RING_OFF, (LAS float*)(F.lds + WSF_OFF)); }
    }
    xcd_barrier(bar);
#if STOP_AFTER == 3
    { const size_t n = (size_t)M * D; for (size_t i = (size_t)blockIdx.x * 512 + F.tid; i < n; i += (size_t)F.G * 512) out[i] = pg8::bf2f(MERGED[i]); }
    return;
#endif

    {
        pg8::Gemm g{MERGED, Wout_t, M, D, D}; pg8::StaticOrder S; S.init(M, D, F.G, (int)blockIdx.x);
        pg8::EpiResid E{x, out, X1B, x1ss};
        pg8::gemm_phase<pg8::EpiResid, pg8::StaticOrder, true, true>(F.lds + RING_OFF, g, S, E);
    }
    xcd_barrier(bar);
#if STOP_AFTER == 4
    return;
#endif

    {
        pg8::Gemm g{X1B, Wffi_t, M, 2 * DFF, D}; pg8::StaticOrder S; S.init(M, 2 * DFF, F.G, (int)blockIdx.x);
        pg8::EpiSwiglu E{ACT, x1ss, DFF};
        pg8::gemm_phase<pg8::EpiSwiglu, pg8::StaticOrder, true, true>(F.lds + RING_OFF, g, S, E);
#if REP_G4 == 2
        pg8::gemm_phase<pg8::EpiSwiglu, pg8::StaticOrder, true, true>(F.lds + RING_OFF, g, S, E);
#endif
    }
    xcd_barrier(bar);
#if STOP_AFTER == 5
    { const size_t n = (size_t)M * D; for (size_t i = (size_t)blockIdx.x * 512 + F.tid; i < n; i += (size_t)F.G * 512) out[i] = pg8::bf2f(ACT[i]) + pg8::bf2f(ACT[i + n]); }
    return;
#endif

    {
        pg8::Gemm g{ACT, Wffo_t, M, D, DFF}; pg8::StaticOrder S; S.init(M, D, F.G, (int)blockIdx.x);
        pg8::EpiResid E{out, out, nullptr, x2ss};
        pg8::gemm_phase<pg8::EpiResid, pg8::StaticOrder, true, true>(F.lds + RING_OFF, g, S, E);
    }
    xcd_barrier(bar);

    {
        const unsigned poison = xb_ld((unsigned*)(F.ctl + CW_BAR) + XB_TMO);
        for (int m = gw; m < M; m += NGW) {
            GAS f32x4* xr = (GAS f32x4*)(out + (size_t)m * D) + F.lane; f32x4 v[4];
#pragma unroll
            for (int j = 0; j < 4; ++j) v[j] = xr[64 * j];
            float s = x2ss[(size_t)m * 16 + (F.lane & 15)];
            s += __shfl_xor(s, 1); s += __shfl_xor(s, 2); s += __shfl_xor(s, 4); s += __shfl_xor(s, 8);
            float rinv = __builtin_amdgcn_rsqf(s * (1.f / D) + 1e-6f);
            if (poison) rinv = __builtin_nanf("");
#pragma unroll
            for (int j = 0; j < 4; ++j) { const f32x4 gg = *((const f32x4*)norm_final_g + F.lane + 64 * j); xr[64 * j] = v[j] * rinv * gg; }
        }
    }
}

extern "C" void kernel_launch(void* const* d_in, const int* in_sizes, int n_in, void* d_out, int out_size, void* d_ws, size_t ws_size, hipStream_t stream) {
    static int grid = 0;
    if (grid == 0) {
        if (n_in != 15 || in_sizes[0] != M * D || out_size != M * D || ws_size < WS_END) { fprintf(stderr, "kernel_launch: unexpected shapes (n_in %d, in0 %d, out %d, ws %zu < %zu); nothing launched\n", n_in, n_in > 0 ? in_sizes[0] : -1, out_size, ws_size, (size_t)WS_END); grid = -1; return; }
        int dev = 0, cus = 0;
        if (hipGetDevice(&dev) != hipSuccess || hipDeviceGetAttribute(&cus, hipDeviceAttributeMultiprocessorCount, dev) != hipSuccess) { fprintf(stderr, "kernel_launch: device query failed\n"); grid = -1; return; }
        if (hipFuncSetAttribute((const void*)skel_fwd, hipFuncAttributeMaxDynamicSharedMemorySize, LDS_BYTES) != hipSuccess) { fprintf(stderr, "kernel_launch: hipFuncSetAttribute failed\n"); grid = -1; return; }
        int per_cu = 0;
        if (hipOccupancyMaxActiveBlocksPerMultiprocessor(&per_cu, (const void*)skel_fwd, NWAVES * 64, LDS_BYTES) != hipSuccess || per_cu < 1) fprintf(stderr, "kernel_launch: note: occupancy query reports %d\n", per_cu);
        (void)hipGetLastError();
        grid = cus;
        if (grid != 256) fprintf(stderr, "kernel_launch: %d CUs; the unit dealing assumes 256\n", grid);
    }
    if (grid < 0) return;
    if (hipMemsetAsync((char*)d_ws + WS_CTL, 0, CTL_ZERO_BYTES, stream) != hipSuccess) { fprintf(stderr, "kernel_launch: hipMemsetAsync failed\n"); return; }
    Args a{};
    for (int i = 0; i < 15; ++i) a.in[i] = (const float*)d_in[i];
    a.out = (float*)d_out; a.ws = (unsigned char*)d_ws;
    hipLaunchKernelGGL(skel_fwd, dim3(grid), dim3(NWAVES * 64), LDS_BYTES, stream, a);
    const hipError_t le = hipPeekAtLastError();
    if (le != hipSuccess) fprintf(stderr, "kernel_launch: launch failed: %s\n", hipGetErrorName(le));
}
```

```cpp
#include <hip/hip_runtime.h>
#include <cstdio>
#include <cstdint>
#ifndef EPI_PLAIN
#define EPI_PLAIN 0
#endif
namespace pg8 {
#define PG8_LAS __attribute__((address_space(3)))
typedef unsigned short bf16_t;
typedef short bf16x8 __attribute__((ext_vector_type(8)));
typedef float f32x4 __attribute__((ext_vector_type(4)));
typedef unsigned u32x4 __attribute__((ext_vector_type(4)));
constexpr int BM = 256, BK = 64, HALF = 128, HTB = HALF * BK * 2  , STAGE_BYTES = 8 * HTB, NXCD = 8, WGM = 8;

__host__ __device__ __forceinline__ int lds_byte(int r, int c) { const int st = (r >> 4) * 2 + (c >> 5), rr = r & 15, cc = c & 31, ob = rr * 64 + cc * 2; return st * 1024 + (ob ^ (((ob >> 9) & 1) << 5)); }
__host__ __device__ __forceinline__ void stage_rc(int b, int& R, int& C) { const int st = b / 1024, sb = b % 1024, swz = sb ^ (((sb >> 9) & 1) << 5); R = (st >> 1) * 16 + swz / 64; C = (st & 1) * 32 + (swz % 64) / 2; }
__host__ __device__ __forceinline__ int perm32(int rho) { const int n = rho >> 4, i = rho & 15; return 8 * (i >> 2) + 4 * n + (i & 3); }

struct Unit { int pm, pn; };
struct Gemm { const bf16_t* A; const bf16_t* Bt; int M, N, K; };

struct StaticOrder {
    int nM, nN, nwg, G, c;
    __host__ __device__ void init(int M, int N, int G_, int c_) { nM = M / BM; nN = N / BM; nwg = nM * nN; G = G_; c = c_; }
    __host__ __device__ bool next(int i, Unit& u) const {
        const long L = (long)i * G + c; if (L >= nwg) return false;
        int wgid = (int)L; { const int q = nwg / NXCD, r = nwg % NXCD, xcd = wgid % NXCD, off = wgid / NXCD; wgid = (xcd < r ? xcd * (q + 1) : r * (q + 1) + (xcd - r) * q) + off; }
        const int nig = WGM * nN, gid = wgid / nig, fm = gid * WGM, gsz = (nM - fm) < WGM ? (nM - fm) : WGM;
        u.pm = fm + ((wgid % nig) % gsz); u.pn = (wgid % nig) / gsz; return true;
    }
    __device__ __forceinline__ void a_ready(const Unit&) const {}
    __device__ __forceinline__ void done(const Unit&) const {}
};

typedef float f32x2c_t __attribute__((ext_vector_type(2))); typedef __bf16 bf16x2c_t __attribute__((ext_vector_type(2)));
__device__ __forceinline__ unsigned cvt_pk_bf16(float lo, float hi) { f32x2c_t v = {lo, hi}; bf16x2c_t b = __builtin_convertvector(v, bf16x2c_t); return __builtin_bit_cast(unsigned, b); }
typedef float f32x2 __attribute__((ext_vector_type(2)));
__device__ __forceinline__ f32x2 gelu_pk(f32x2 v) {
    const f32x2 av = __builtin_elementwise_abs(v), d = av * 0.2316418882f + 1.0f;
    f32x2 t; t.x = __builtin_amdgcn_rcpf(d.x); t.y = __builtin_amdgcn_rcpf(d.y);
    f32x2 q = t * 0.5307027145f + (-0.7265760135f); q = q * t + 0.7107068705f; q = q * t + (-0.142248368f); q = q * t + 0.127414796f; q = q * t;
    const f32x2 s = (v * v) * (-0.72134752044f);
    f32x2 e; e.x = __builtin_amdgcn_exp2f(s.x); e.y = __builtin_amdgcn_exp2f(s.y);
    const f32x2 m = v * (q * e), r = v - m;
    f32x2 o; o.x = v.x < 0.f ? m.x : r.x; o.y = v.y < 0.f ? m.y : r.y; return o;
}

__device__ __forceinline__ float bf2f(unsigned short h) { return __uint_as_float((unsigned)h << 16); }
__device__ __forceinline__ float sigm(float x) { return __builtin_amdgcn_rcpf(1.0f + __builtin_amdgcn_exp2f(-1.4426950408889634f * x)); }
__device__ __forceinline__ f32x4 gelu4(f32x4 v) { const f32x2 a = gelu_pk((f32x2){v[0], v[1]}), b = gelu_pk((f32x2){v[2], v[3]}); return (f32x4){a.x, a.y, b.x, b.y}; }
__device__ __forceinline__ float dot4(f32x4 v) { return (v[0] * v[0] + v[1] * v[1]) + (v[2] * v[2] + v[3] * v[3]); }

struct EpiProj {
    static constexpr bool PERM = true, AFTER_DRAIN = false;
    bf16_t* dst5; bf16_t* dstg; const float* rope; const float* gate_b; const float* gnorm; float* gvss; float qscale;
    template <int KIND> __device__ __forceinline__ void body(const f32x4 (&acc)[2][2][4][2], const Unit& u, int seg, int wr, int wc, int fr, int fq) const {
        const int colt = (u.pn & 3) * BM;
        const int row0 = u.pm * BM + wr * 64 + fr, col0 = colt + wc * 32 + 8 * fq;
        bf16_t* base = (seg < 5) ? dst5 + (size_t)seg * ((size_t)32768 * 1024) : dstg + (size_t)(seg - 5) * ((size_t)32768 * 1024);
        const float sc = (seg == 0) ? qscale : 1.f;
        const bool rotw = (KIND == 0) && ((wc & 1) == 0);
        f32x4 cv[2][2];
        if (KIND == 3 || KIND == 4) { const float* p = (KIND == 3) ? gnorm : gate_b + (seg - 5) * 1024;
#pragma unroll
            for (int bj = 0; bj < 2; ++bj)
#pragma unroll
                for (int n = 0; n < 2; ++n) cv[bj][n] = *(const f32x4*)(p + col0 + bj * HALF + 4 * n); }
#pragma unroll
        for (int ai = 0; ai < 2; ++ai)
#pragma unroll
            for (int m = 0; m < 4; ++m) {
                const int row = row0 + ai * HALF + m * 16;
                f32x4 cs0, cs1, sn0, sn1;
                if (KIND == 0) { if (rotw) { const f32x4* rp = (const f32x4*)(rope + (size_t)row * 16); const f32x4 c0 = rp[0], c1 = rp[1], s0 = rp[2], s1 = rp[3];
                    const float sg = (fq == 0) ? -1.f : ((fq == 1) ? 1.f : 0.f); const bool rl = fq < 2;
                    cs0 = rl ? c0 : (f32x4){1.f, 1.f, 1.f, 1.f}; cs1 = rl ? c1 : (f32x4){1.f, 1.f, 1.f, 1.f}; sn0 = s0 * sg; sn1 = s1 * sg; } }
                float ss = 0.f;
                bf16_t* rowp = base + (size_t)row * 1024 + col0;
#pragma unroll
                for (int bj = 0; bj < 2; ++bj) {
                    f32x4 v0 = acc[ai][bj][m][0], v1 = acc[ai][bj][m][1];
                    if (KIND == 0) {
                        if (rotw) { f32x4 p0, p1;
#pragma unroll
                            for (int i = 0; i < 4; ++i) { p0[i] = __shfl_xor(v0[i], 16); p1[i] = __shfl_xor(v1[i], 16); }
                            v0 = v0 * cs0 + p0 * sn0; v1 = v1 * cs1 + p1 * sn1; }
                        v0 = v0 * sc; v1 = v1 * sc;
                    }
                    if (KIND == 2 || KIND == 3) { v0 = gelu4(v0); v1 = gelu4(v1); }
                    if (KIND == 3) { ss += dot4(v0) + dot4(v1); v0 = v0 * cv[bj][0]; v1 = v1 * cv[bj][1]; }
                    if (KIND == 4) { v0 = v0 + cv[bj][0]; v1 = v1 + cv[bj][1];
#pragma unroll
                        for (int i = 0; i < 4; ++i) { v0[i] = sigm(v0[i]); v1[i] = sigm(v1[i]); } }
                    u32x4 w; w.x = cvt_pk_bf16(v0[0], v0[1]); w.y = cvt_pk_bf16(v0[2], v0[3]); w.z = cvt_pk_bf16(v1[0], v1[1]); w.w = cvt_pk_bf16(v1[2], v1[3]);
                    *(u32x4*)(rowp + bj * HALF) = w;
                }
                if (KIND == 3) { ss += __shfl_xor(ss, 16); ss += __shfl_xor(ss, 32); if (fq == 0) __hip_atomic_store(gvss + (size_t)row * 16 + (u.pn & 3) * 4 + wc, ss, __ATOMIC_RELAXED, __HIP_MEMORY_SCOPE_AGENT); }
            }
    }
    __device__ __forceinline__ void operator()(const f32x4 (&acc)[2][2][4][2], const Unit& u, int wr, int wc, int fr, int fq) const {
        const int seg = u.pn >> 2;
#if EPI_PLAIN
        body<1>(acc, u, seg, wr, wc, fr, fq); return;
#endif
        if (seg <= 1) body<0>(acc, u, seg, wr, wc, fr, fq);
        else if (seg == 2) body<1>(acc, u, seg, wr, wc, fr, fq);
        else if (seg == 3) body<2>(acc, u, seg, wr, wc, fr, fq);
        else if (seg == 4) body<3>(acc, u, seg, wr, wc, fr, fq);
        else body<4>(acc, u, seg, wr, wc, fr, fq);
    }
};

struct EpiResid {
    static constexpr bool PERM = false, AFTER_DRAIN = false;
    const float* base; float* out; bf16_t* xb; float* ss;
    __device__ __forceinline__ void operator()(const f32x4 (&acc)[2][2][4][2], const Unit& u, int wr, int wc, int fr, int fq) const {
        typedef unsigned u32x2v __attribute__((ext_vector_type(2)));
        const int row0 = u.pm * BM + wr * 64 + fr, col0 = u.pn * BM + wc * 32 + 4 * fq;
#pragma unroll
        for (int ai = 0; ai < 2; ++ai)
#pragma unroll
            for (int m = 0; m < 4; ++m) {
                const int row = row0 + ai * HALF + m * 16; const size_t off = (size_t)row * 1024 + col0; float s = 0.f;
#pragma unroll
                for (int bj = 0; bj < 2; ++bj)
#pragma unroll
                    for (int n = 0; n < 2; ++n) {
                        const f32x4 bs = *(const f32x4*)(base + off + bj * HALF + n * 16); const f32x4 o = bs + acc[ai][bj][m][n];
                        *(f32x4*)(out + off + bj * HALF + n * 16) = o; s += dot4(o);
                        if (xb) { u32x2v w; w.x = cvt_pk_bf16(o[0], o[1]); w.y = cvt_pk_bf16(o[2], o[3]); *(u32x2v*)(xb + off + bj * HALF + n * 16) = w; }
                    }
                s += __shfl_xor(s, 16); s += __shfl_xor(s, 32);
                if (fq == 0) __hip_atomic_store(ss + (size_t)row * 16 + u.pn * 4 + wc, s, __ATOMIC_RELAXED, __HIP_MEMORY_SCOPE_AGENT);
                if (m & 1) asm volatile("" ::: "memory");
            }
    }
};

struct EpiSwiglu {
    static constexpr bool PERM = true, AFTER_DRAIN = false;
    bf16_t* act; const float* ss; int ldc;
    __device__ __forceinline__ void operator()(const f32x4 (&acc)[2][2][4][2], const Unit& u, int wr, int wc, int fr, int fq) const {
        const int row0 = u.pm * BM + wr * 64 + fr, col0 = u.pn * HALF + wc * 32 + 8 * fq;
#pragma unroll
        for (int ai = 0; ai < 2; ++ai)
#pragma unroll
            for (int m = 0; m < 4; ++m) {
                const int row = row0 + ai * HALF + m * 16;
                const f32x4* sp = (const f32x4*)(ss + (size_t)row * 16); const f32x4 t = (sp[0] + sp[1]) + (sp[2] + sp[3]);
                const float rinv = __builtin_amdgcn_rsqf(((t[0] + t[1]) + (t[2] + t[3])) * (1.0f / 1024.0f) + 1e-6f);
                f32x4 h[2];
#pragma unroll
                for (int n = 0; n < 2; ++n) { const f32x4 a = acc[ai][0][m][n] * rinv, b = acc[ai][1][m][n] * rinv;
#pragma unroll
                    for (int i = 0; i < 4; ++i) h[n][i] = a[i] * sigm(a[i]) * b[i]; }
                u32x4 w; w.x = cvt_pk_bf16(h[0][0], h[0][1]); w.y = cvt_pk_bf16(h[0][2], h[0][3]); w.z = cvt_pk_bf16(h[1][0], h[1][1]); w.w = cvt_pk_bf16(h[1][2], h[1][3]);
                *(u32x4*)(act + (size_t)row * ldc + col0) = w;
            }
    }
};

template <class Epi, class Sched, bool ALIGN_EPI = false, bool SP2 = false>
__device__ __forceinline__ void gemm_phase(PG8_LAS unsigned char* lds, const Gemm g, const Sched& S, const Epi& E) {
    const int tid = threadIdx.x, wid = __builtin_amdgcn_readfirstlane(tid >> 6), lane = tid & 63, wr = wid >> 2, wc = wid & 3, fr = lane & 15, fq = lane >> 4;
    const int K = g.K, nt = K / BK;
    unsigned voffA[2], voffB[2];
#pragma unroll
    for (int i = 0; i < 2; ++i) { int R, C; stage_rc(tid * 16 + i * 8192, R, C); const int Rb = Epi::PERM ? ((R & ~31) + perm32(R & 31)) : R;
        voffA[i] = (unsigned)(R * K + C) * 2u; voffB[i] = (unsigned)(Rb * K + C) * 2u; }
    const size_t kstep = (size_t)(BK * 2);
    const size_t hstep = (size_t)HALF * K * 2;
    const size_t tstep = 2 * hstep;
    const unsigned ldsw = (unsigned)wid * 1024u;
    const int aoff = lds_byte(wr * 64 + fr, fq * 8), boff = lds_byte(wc * 32 + fr, fq * 8);
#define PG8_SA(b, h) (((b) * 2 + (h)) * HTB)
#define PG8_SB(b, h) ((4 + (b) * 2 + (h)) * HTB)
#define PG8_STAGE(bufoff, gbase, voff) do { _Pragma("unroll") for (int _i = 0; _i < 2; ++_i) \
        __builtin_amdgcn_global_load_lds((const unsigned*)((const char*)(gbase) + (voff)[_i]), (PG8_LAS unsigned*)(lds + (bufoff) + ldsw + _i * 8192), 16, 0, 0); } while (0)
#define PG8_LDA(dst, b, h) do { _Pragma("unroll") for (int m = 0; m < 4; ++m) _Pragma("unroll") for (int k = 0; k < 2; ++k) dst[m][k] = *(const PG8_LAS bf16x8*)(lds + PG8_SA(b, h) + aoff + m * 2048 + k * 1024); } while (0)
#define PG8_LDB(dst, b, h) do { _Pragma("unroll") for (int n = 0; n < 2; ++n) _Pragma("unroll") for (int k = 0; k < 2; ++k) dst[n][k] = *(const PG8_LAS bf16x8*)(lds + PG8_SB(b, h) + boff + n * 2048 + k * 1024); } while (0)
#define PG8_MMA(ai, bj, At, Bt) do { __builtin_amdgcn_s_setprio(1); _Pragma("unroll") for (int m = 0; m < 4; ++m) _Pragma("unroll") for (int n = 0; n < 2; ++n) _Pragma("unroll") for (int k = 0; k < 2; ++k) \
        acc[ai][bj][m][n] = __builtin_amdgcn_mfma_f32_16x16x32_bf16(Bt[n][k], At[m][k], acc[ai][bj][m][n], 0, 0, 0); __builtin_amdgcn_s_setprio(0); } while (0)
#define PG8_WAIT_V(n) asm volatile("s_waitcnt vmcnt(" #n ")" ::: "memory")
#define PG8_WAIT_L(n) asm volatile("s_waitcnt lgkmcnt(" #n ")" ::: "memory")
#define PG8_BAR __builtin_amdgcn_s_barrier()
#define PG8_SCHED __builtin_amdgcn_sched_barrier(0)
    Unit cur, nxt; int ui = 0;
    if (!S.next(0, cur)) return;
    f32x4 acc[2][2][4][2];
#pragma unroll
    for (int a = 0; a < 2; ++a)
#pragma unroll
        for (int b = 0; b < 2; ++b)
#pragma unroll
            for (int m = 0; m < 4; ++m)
#pragma unroll
                for (int n = 0; n < 2; ++n) acc[a][b][m][n] = (f32x4){0.f, 0.f, 0.f, 0.f};
    bf16x8 At[4][2], B0[2][2], B1[2][2];
    const char* cA = (const char*)g.A + (size_t)cur.pm * tstep; const char* cB = (const char*)g.Bt + (size_t)cur.pn * tstep;
    S.a_ready(cur);
    if constexpr (SP2) {
        PG8_STAGE(PG8_SB(0, 0), cB, voffB); PG8_STAGE(PG8_SB(0, 1), cB + hstep, voffB); PG8_STAGE(PG8_SA(0, 0), cA, voffA); PG8_STAGE(PG8_SA(0, 1), cA + hstep, voffA);
        if (wr == 1) PG8_BAR;
        PG8_WAIT_V(2); PG8_BAR;
        PG8_STAGE(PG8_SB(1, 0), cB + kstep, voffB); PG8_STAGE(PG8_SA(1, 0), cA + kstep, voffA); PG8_STAGE(PG8_SB(1, 1), cB + hstep + kstep, voffB);
        PG8_WAIT_V(6); PG8_BAR;
    } else {
        PG8_STAGE(PG8_SB(0, 0), cB, voffB); PG8_STAGE(PG8_SA(0, 0), cA, voffA); PG8_STAGE(PG8_SB(0, 1), cB + hstep, voffB); PG8_STAGE(PG8_SA(0, 1), cA + hstep, voffA);
        if (wr == 1) PG8_BAR;
        PG8_WAIT_V(4); PG8_BAR;
        PG8_STAGE(PG8_SB(1, 0), cB + kstep, voffB); PG8_STAGE(PG8_SA(1, 0), cA + kstep, voffA); PG8_STAGE(PG8_SB(1, 1), cB + hstep + kstep, voffB);
        PG8_WAIT_V(6); PG8_BAR;
    }
    for (;;) {
        const bool has_next = S.next(ui + 1, nxt);
        const char* nA = has_next ? (const char*)g.A + (size_t)nxt.pm * tstep : cA; const char* nB = has_next ? (const char*)g.Bt + (size_t)nxt.pn * tstep : cB;
        for (int t = 0; t < nt; t += 2) {
            const bool last = (t == nt - 2);
            const char* a1 = cA + (size_t)(t + 1) * kstep;
            const char* a2 = last ? nA : cA + (size_t)(t + 2) * kstep; const char* b2 = last ? nB : cB + (size_t)(t + 2) * kstep;
            const char* a3 = a2 + kstep; const char* b3 = b2 + kstep;
            if (last && has_next) S.a_ready(nxt);
            if constexpr (SP2) {
            PG8_LDB(B0, 0, 0); PG8_LDB(B1, 0, 1); PG8_SCHED; PG8_LDA(At, 0, 0); PG8_STAGE(PG8_SA(1, 1), a1 + hstep, voffA);
            PG8_WAIT_V(8); PG8_WAIT_L(0); PG8_BAR; PG8_MMA(0, 0, At, B0); PG8_MMA(0, 1, At, B1); PG8_BAR; PG8_SCHED;
            PG8_LDA(At, 0, 1); PG8_STAGE(PG8_SB(0, 0), b2, voffB); PG8_STAGE(PG8_SB(0, 1), b2 + hstep, voffB); PG8_STAGE(PG8_SA(0, 0), a2, voffA);
            PG8_WAIT_V(8); PG8_WAIT_L(0); PG8_BAR; PG8_MMA(1, 0, At, B0); PG8_MMA(1, 1, At, B1); PG8_BAR; PG8_SCHED;
            PG8_LDB(B0, 1, 0); PG8_LDB(B1, 1, 1); PG8_SCHED; PG8_LDA(At, 1, 0); PG8_STAGE(PG8_SA(0, 1), a2 + hstep, voffA);
            PG8_WAIT_V(8); PG8_WAIT_L(0); PG8_BAR; PG8_MMA(0, 0, At, B0); PG8_MMA(0, 1, At, B1); PG8_BAR; PG8_SCHED;
            PG8_LDA(At, 1, 1); PG8_STAGE(PG8_SB(1, 0), b3, voffB); PG8_STAGE(PG8_SB(1, 1), b3 + hstep, voffB); PG8_STAGE(PG8_SA(1, 0), a3, voffA);
            PG8_WAIT_V(8); PG8_WAIT_L(0); PG8_BAR; PG8_MMA(1, 0, At, B0); PG8_MMA(1, 1, At, B1); PG8_BAR; PG8_SCHED;
            } else {
            PG8_LDB(B0, 0, 0); PG8_SCHED; PG8_LDA(At, 0, 0); PG8_STAGE(PG8_SA(1, 1), a1 + hstep, voffA);
            PG8_WAIT_L(8); PG8_BAR; PG8_WAIT_L(0); PG8_MMA(0, 0, At, B0); PG8_BAR; PG8_SCHED;
            PG8_LDB(B1, 0, 1); PG8_STAGE(PG8_SB(0, 0), b2, voffB);
            PG8_BAR; PG8_WAIT_L(0); PG8_MMA(0, 1, At, B1); PG8_BAR;
            PG8_LDA(At, 0, 1); PG8_STAGE(PG8_SA(0, 0), a2, voffA);
            PG8_BAR; PG8_WAIT_L(0); PG8_MMA(1, 0, At, B0); PG8_BAR; PG8_SCHED;
            PG8_STAGE(PG8_SB(0, 1), b2 + hstep, voffB);
            PG8_WAIT_V(6); PG8_BAR; PG8_MMA(1, 1, At, B1); PG8_BAR;
            PG8_LDB(B0, 1, 0); PG8_SCHED; PG8_LDA(At, 1, 0); PG8_STAGE(PG8_SA(0, 1), a2 + hstep, voffA);
            PG8_WAIT_L(8); PG8_BAR; PG8_WAIT_L(0); PG8_MMA(0, 0, At, B0); PG8_BAR; PG8_SCHED;
            PG8_LDB(B1, 1, 1); PG8_STAGE(PG8_SB(1, 0), b3, voffB);
            PG8_BAR; PG8_WAIT_L(0); PG8_MMA(0, 1, At, B1); PG8_BAR;
            PG8_LDA(At, 1, 1); PG8_STAGE(PG8_SA(1, 0), a3, voffA);
            PG8_BAR; PG8_WAIT_L(0); PG8_MMA(1, 0, At, B0); PG8_BAR; PG8_SCHED;
            PG8_STAGE(PG8_SB(1, 1), b3 + hstep, voffB);
            PG8_WAIT_V(6); PG8_BAR; PG8_MMA(1, 1, At, B1); PG8_BAR;
            }
        }
        if constexpr (ALIGN_EPI) { if (wr == 0) PG8_BAR; }
        if constexpr (!Epi::AFTER_DRAIN) { E(acc, cur, wr, wc, fr, fq); S.done(cur); }
        if (!has_next) break;
#pragma unroll
        for (int a = 0; a < 2; ++a)
#pragma unroll
            for (int b = 0; b < 2; ++b)
#pragma unroll
                for (int m = 0; m < 4; ++m)
#pragma unroll
                    for (int n = 0; n < 2; ++n) acc[a][b][m][n] = (f32x4){0.f, 0.f, 0.f, 0.f};
        cur = nxt; cA = nA; cB = nB; ++ui;
        if constexpr (ALIGN_EPI) { if (wr == 1) PG8_BAR; }
    }
    PG8_WAIT_V(0);
    if constexpr (!ALIGN_EPI) { if (wr == 0) PG8_BAR; }
    PG8_BAR;
    if constexpr (Epi::AFTER_DRAIN) { E.fused(acc, cur, wr, wc, fr, fq, lds, wid, lane); S.done(cur); }
#undef PG8_SA
#undef PG8_SB
#undef PG8_STAGE
#undef PG8_LDA
#undef PG8_LDB
#undef PG8_MMA
#undef PG8_WAIT_V
#undef PG8_WAIT_L
#undef PG8_BAR
#undef PG8_SCHED
}
}
namespace dattn {
#define DLAS __attribute__((address_space(3)))
typedef unsigned short bf16_t;
using bf16x8 = __attribute__((ext_vector_type(8))) short;
using s16x4 = __attribute__((ext_vector_type(4))) short;
using f32x16 = __attribute__((ext_vector_type(16))) float;
using f32x4 = __attribute__((ext_vector_type(4))) float;
using u32x4 = __attribute__((ext_vector_type(4))) unsigned;
typedef short v4i16_t __attribute__((ext_vector_type(4)));
constexpr int SEQ = 2048, DM = 1024, QB = 128, KVBLK = 64;
constexpr int SLOTB = 32768, OFF_K1 = 0, OFF_K2 = 8192, OFF_V = 16384;
constexpr float C2 = 0.125f * 1.4426950408889634f;
constexpr float THR = 8.0f;
__device__ __forceinline__ int crow(int r, int hi) { return (r & 3) + 8 * (r >> 2) + 4 * hi; }
__device__ __forceinline__ void glds16(const void* gsrc, unsigned lds_dst) { unsigned keep;
    asm volatile("s_mov_b32 %0, m0\n\ts_mov_b32 m0, %2\n\ts_nop 0\n\tglobal_load_lds_dwordx4 %1, off\n\ts_mov_b32 m0, %0" : "=&s"(keep) : "v"(gsrc), "s"(lds_dst) : "memory"); }
__device__ __forceinline__ s16x4 vtr(const DLAS unsigned char* p) { return __builtin_bit_cast(s16x4, __builtin_amdgcn_ds_read_tr16_b64_v4i16((DLAS v4i16_t*)p)); }
__device__ __forceinline__ float bf2f(unsigned short h) { return __uint_as_float((unsigned)h << 16); }
typedef float f32x2_t __attribute__((ext_vector_type(2))); typedef __bf16 bf16x2_t __attribute__((ext_vector_type(2)));
__device__ __forceinline__ unsigned cvtpk(float lo, float hi) { f32x2_t v = {lo, hi}; bf16x2_t b = __builtin_convertvector(v, bf16x2_t); return __builtin_bit_cast(unsigned, b); }
#define MX3(a, b, c) __builtin_fmaxf(__builtin_fmaxf((a), (b)), (c))
__device__ __forceinline__ float rowmax(const f32x16& p0, const f32x16& p1) {
    float a = MX3(p0[0], p0[1], p1[0]), b = MX3(p0[2], p0[3], p1[1]); a = MX3(a, p1[2], p1[3]);
#pragma unroll
    for (int r = 4; r < 16; r += 4) { a = MX3(a, p0[r], p0[r + 1]); b = MX3(b, p0[r + 2], p0[r + 3]); a = MX3(a, p1[r], p1[r + 1]); b = MX3(b, p1[r + 2], p1[r + 3]); }
    float m = __builtin_fmaxf(a, b); auto rr = __builtin_amdgcn_permlane32_swap(__float_as_uint(m), __float_as_uint(m), false, false);
    return __builtin_fmaxf(__uint_as_float(rr[0]), __uint_as_float(rr[1])); }
#define MFMA32(a, b, c) __builtin_amdgcn_mfma_f32_32x32x16_bf16(a, b, c, 0, 0, 0)
#define WAIT_BAR(N) asm volatile("s_waitcnt vmcnt(" #N ") lgkmcnt(0)\n\ts_barrier" ::: "memory")
#define BAR_ALL() asm volatile("s_waitcnt vmcnt(0) lgkmcnt(0)\n\ts_barrier" ::: "memory")

__device__ __forceinline__ void unit(int b, int h, int qb, const bf16_t* Q, const bf16_t* K, const bf16_t* V, const bf16_t* G0, const bf16_t* GM, bf16_t* MERGED,
                                     const float* subln_g, float lam, DLAS unsigned char* shm, DLAS float* wsf_base) {
    const int tid = threadIdx.x, lane = tid & 63, r32 = lane & 31, hi = lane >> 5; const int wid = __builtin_amdgcn_readfirstlane(tid >> 6);
    const int map = wid >> 2, rq = wid & 3;
    const long rowbase = (long)b * SEQ; const int q0 = qb * QB;
    const int NT = 2 * qb + 2, myNT = (rq < 2) ? NT - 1 : NT;
    const bf16_t* Qw = Q + (rowbase + q0 + rq * 32) * DM + h * 128 + map * 64;
    const bf16_t* Kh = K + rowbase * DM + h * 128; const bf16_t* Vh = V + rowbase * DM + h * 128;
    const unsigned lds0 = (unsigned)(uintptr_t)shm;
    DLAS float* wsf = wsf_base + wid * 64;
    const bf16_t* ksrc1 = Kh + (long)lane * DM + wid * 8; const bf16_t* ksrc2 = ksrc1 + 64;
    const bf16_t* vsrcA = Vh + (long)(16 * (wid & 3) + (lane >> 2)) * DM + (wid >> 2) * 32 + (lane & 3) * 8; const bf16_t* vsrcB = vsrcA + 64;
    const unsigned dK1 = lds0 + OFF_K1 + wid * 1024, dK2 = lds0 + OFF_K2 + wid * 1024, dVA = lds0 + OFF_V + wid * 1024, dVB = lds0 + OFF_V + (wid + 8) * 1024;
#define RFL(x) ((unsigned)__builtin_amdgcn_readfirstlane(x))
#define DMA_T(t, slot) do { const long go_ = (long)(t) * KVBLK * DM; glds16(ksrc1 + go_, RFL(dK1 + (slot))); glds16(ksrc2 + go_, RFL(dK2 + (slot))); glds16(vsrcA + go_, RFL(dVA + (slot))); glds16(vsrcB + go_, RFL(dVB + (slot))); } while (0)
    const DLAS unsigned char* kp0 = shm + (map ? OFF_K2 : OFF_K1) + hi * 1024 + r32 * 16;
    const DLAS unsigned char* vp0 = shm + OFF_V + ((lane >> 4) & 1) * 32 + (lane & 3) * 8 + (4 * hi + ((lane & 15) >> 2)) * 64;
    bf16x8 qr[4];
#pragma unroll
    for (int d0 = 0; d0 < 4; ++d0) qr[d0] = *reinterpret_cast<const bf16x8*>(Qw + (long)r32 * DM + d0 * 16 + hi * 8);
    DMA_T(0, 0); DMA_T(1, SLOTB);
    float mref = 0.f, l_reg = 0.f; f32x16 o[4]; o[0] = f32x16{}; o[1] = f32x16{}; o[2] = f32x16{}; o[3] = f32x16{};
    f32x16 negm = f32x16{};
    int sl_cur = 0, sl_nn = 2 * SLOTB;
    for (int t = 0; t < NT; ++t) {
        if (t + 1 < NT) { WAIT_BAR(4); } else { WAIT_BAR(0); }
        if (t + 2 < NT) DMA_T(t + 2, sl_nn);
        if (t < myNT) {
            const DLAS unsigned char* kp = kp0 + sl_cur; const DLAS unsigned char* vp = vp0 + sl_cur;
            f32x16 p0 = negm, p1 = negm;
#pragma unroll
            for (int d0 = 0; d0 < 4; ++d0) {
                const bf16x8 k0 = *(const DLAS bf16x8*)(kp + d0 * 2048), k1 = *(const DLAS bf16x8*)(kp + d0 * 2048 + 512);
                p0 = MFMA32(k0, qr[d0], p0); p1 = MFMA32(k1, qr[d0], p1);
            }
            const float rm = rowmax(p0, p1);
            if (t == 0 || __any(rm > THR)) {
                const float dl = (t == 0) ? rm : __builtin_fmaxf(rm, 0.f);
                mref += dl;
#pragma unroll
                for (int r = 0; r < 16; ++r) { p0[r] -= dl; p1[r] -= dl; }
#pragma unroll
                for (int r = 0; r < 16; ++r) negm[r] = -mref;
                if (t != 0) {
                    const float f = __builtin_amdgcn_exp2f(-dl); l_reg *= f;
                    if (hi == 0) wsf[r32] = f;
                    asm volatile("s_waitcnt lgkmcnt(0)" ::: "memory");
                    float a[16];
#pragma unroll
                    for (int r = 0; r < 16; ++r) a[r] = wsf[crow(r, hi)];
#pragma unroll
                    for (int d = 0; d < 4; ++d)
#pragma unroll
                        for (int r = 0; r < 16; ++r) o[d][r] *= a[r];
                }
            }
            float sacc = 0.f;
#pragma unroll
            for (int r = 0; r < 16; ++r) { p0[r] = __builtin_amdgcn_exp2f(p0[r]); p1[r] = __builtin_amdgcn_exp2f(p1[r]); sacc += p0[r] + p1[r]; }
            l_reg += sacc;
            u32x4 pw[4];
            pw[0] = (u32x4){cvtpk(p0[0], p0[1]), cvtpk(p0[2], p0[3]), cvtpk(p0[4], p0[5]), cvtpk(p0[6], p0[7])};
            pw[1] = (u32x4){cvtpk(p0[8], p0[9]), cvtpk(p0[10], p0[11]), cvtpk(p0[12], p0[13]), cvtpk(p0[14], p0[15])};
            pw[2] = (u32x4){cvtpk(p1[0], p1[1]), cvtpk(p1[2], p1[3]), cvtpk(p1[4], p1[5]), cvtpk(p1[6], p1[7])};
            pw[3] = (u32x4){cvtpk(p1[8], p1[9]), cvtpk(p1[10], p1[11]), cvtpk(p1[12], p1[13]), cvtpk(p1[14], p1[15])};
#pragma unroll
            for (int dq = 0; dq < 4; ++dq) {
#pragma unroll
                for (int ks = 0; ks < 4; ++ks) {
                    const s16x4 lo = vtr(vp + dq * 4096 + ks * 1024), hh = vtr(vp + dq * 4096 + ks * 1024 + 512);
                    const bf16x8 vf = (bf16x8){lo[0], lo[1], lo[2], lo[3], hh[0], hh[1], hh[2], hh[3]};
                    o[dq] = MFMA32(__builtin_bit_cast(bf16x8, pw[ks]), vf, o[dq]);
                }
            }
        }
        sl_cur = (sl_cur == 2 * SLOTB) ? 0 : sl_cur + SLOTB; sl_nn = (sl_nn == 2 * SLOTB) ? 0 : sl_nn + SLOTB;
    }
    { auto rr = __builtin_amdgcn_permlane32_swap(__float_as_uint(l_reg), __float_as_uint(l_reg), false, false); l_reg = __uint_as_float(rr[0]) + __uint_as_float(rr[1]); }
    if (hi == 0) wsf[32 + r32] = l_reg;
    asm volatile("s_waitcnt lgkmcnt(0)" ::: "memory");
    float rli[16];
#pragma unroll
    for (int r = 0; r < 16; ++r) rli[r] = __builtin_amdgcn_rcpf(wsf[32 + crow(r, hi)]);
    BAR_ALL();
    DLAS float* st = (DLAS float*)shm;
#pragma unroll
    for (int r = 0; r < 16; ++r) { const int row = map * 128 + rq * 32 + crow(r, hi);
#pragma unroll
        for (int dq = 0; dq < 4; ++dq) st[row * 128 + dq * 32 + r32] = o[dq][r] * rli[r]; }
    BAR_ALL();
#pragma unroll
    for (int ps = 0; ps < 4; ++ps) {
        const int item = ps * 512 + tid, row = item >> 4, ch = item & 15;
        const DLAS f32x4* p1 = (const DLAS f32x4*)(st + row * 128 + ch * 8); const DLAS f32x4* p2 = (const DLAS f32x4*)(st + 16384 + row * 128 + ch * 8);
        const f32x4 o0 = p1[0] - p2[0] * lam, o1 = p1[1] - p2[1] * lam;
        float ss = ((o0[0] * o0[0] + o0[1] * o0[1]) + (o0[2] * o0[2] + o0[3] * o0[3])) + ((o1[0] * o1[0] + o1[1] * o1[1]) + (o1[2] * o1[2] + o1[3] * o1[3]));
        ss += __shfl_xor(ss, 1); ss += __shfl_xor(ss, 2); ss += __shfl_xor(ss, 4); ss += __shfl_xor(ss, 8);
        const float rinv = __builtin_amdgcn_rsqf(ss * (1.0f / 128.0f) + 1e-5f) * 0.8f;
        const size_t gi = (size_t)(rowbase + q0 + row) * DM + h * 128 + ch * 8;
        const u32x4 g0v = *(const u32x4*)(G0 + gi), gmv = *(const u32x4*)(GM + gi);
        const f32x4 sg0 = *(const f32x4*)(subln_g + ch * 8), sg1 = *(const f32x4*)(subln_g + ch * 8 + 4);
        float y[8];
#pragma unroll
        for (int i = 0; i < 4; ++i) { y[i] = o0[i] * rinv * sg0[i]; y[4 + i] = o1[i] * rinv * sg1[i]; }
        u32x4 w;
#pragma unroll
        for (int i = 0; i < 4; ++i) {
            const unsigned gg = g0v[i], mm = gmv[i];
            const float lo = __uint_as_float(gg << 16) * y[2 * i] + __uint_as_float(mm << 16), hh = __uint_as_float(gg & 0xffff0000u) * y[2 * i + 1] + __uint_as_float(mm & 0xffff0000u);
            w[i] = cvtpk(lo, hh);
        }
        *(u32x4*)(MERGED + gi) = w;
    }
    BAR_ALL();
#undef DMA_T
#undef RFL
}

constexpr int GST = 132;
__device__ __forceinline__ void gmlp_unit(int b, int n, int g, const bf16_t* GV, const bf16_t* GU, const bf16_t* G1, const float* gvss, const bf16_t* Wp, const float* bs, bf16_t* GM,
                                          DLAS unsigned char* shm) {
    const int tid = threadIdx.x, lane = tid & 63, r32 = lane & 31, hi = lane >> 5; const int wid = __builtin_amdgcn_readfirstlane(tid >> 6);
    const long rowbase = (long)b * SEQ + n * 128;
    DLAS float* rin = (DLAS float*)(shm + 32768);
    DLAS float* st = (DLAS float*)(shm + 36864);
    u32x4 guv[4], g1v[4];
#pragma unroll
    for (int it = 0; it < 4; ++it) { const int item = it * 512 + tid, row = item >> 4, c16 = item & 15; const size_t gi = (size_t)(rowbase + row) * DM + g * 128 + c16 * 8;
        guv[it] = *(const u32x4*)(GU + gi); g1v[it] = *(const u32x4*)(G1 + gi); }
    if (tid < 128) { const f32x4* sp = (const f32x4*)(gvss + (size_t)(rowbase + tid) * 16); const f32x4 t = (sp[0] + sp[1]) + (sp[2] + sp[3]);
        rin[tid] = __builtin_amdgcn_rsqf(((t[0] + t[1]) + (t[2] + t[3])) * (1.0f / 1024.0f) + 1e-6f); }
    u32x4 vv[4];
#pragma unroll
    for (int it = 0; it < 4; ++it) { const int item = it * 512 + tid, row = item >> 4, c16 = item & 15; vv[it] = *(const u32x4*)(GV + (size_t)(rowbase + row) * DM + g * 128 + c16 * 8); }
    __syncthreads();
#pragma unroll
    for (int it = 0; it < 4; ++it) {
        const int item = it * 512 + tid, row = item >> 4, c16 = item & 15; const float ri = rin[row]; const u32x4 v = vv[it];
        u32x4 w;
#pragma unroll
        for (int i = 0; i < 4; ++i) w[i] = cvtpk(__uint_as_float(v[i] << 16) * ri, __uint_as_float(v[i] & 0xffff0000u) * ri);
        *(DLAS u32x4*)(shm + (c16 >> 2) * 8192 + row * 64 + (c16 & 3) * 16) = w;
    }
    __syncthreads();
    const int ib = wid >> 1, cb0 = 2 * (wid & 1), nks = (ib < 2) ? 4 : 8;
    const DLAS unsigned char* vp0 = shm + ((lane >> 4) & 1) * 32 + (lane & 3) * 8 + (4 * hi + ((lane & 15) >> 2)) * 64;
    const bf16_t* wrow = Wp + ((size_t)(g * 128 + ib * 32 + r32)) * 128 + hi * 8;
    f32x16 acc[2]; acc[0] = f32x16{}; acc[1] = f32x16{};
    for (int ks = 0; ks < nks; ++ks) {
        const bf16x8 a = *(const bf16x8*)(wrow + ks * 16);
#pragma unroll
        for (int c = 0; c < 2; ++c) {
            const s16x4 lo = vtr(vp0 + (cb0 + c) * 8192 + ks * 1024), hh = vtr(vp0 + (cb0 + c) * 8192 + ks * 1024 + 512);
            const bf16x8 vf = (bf16x8){lo[0], lo[1], lo[2], lo[3], hh[0], hh[1], hh[2], hh[3]};
            acc[c] = MFMA32(a, vf, acc[c]);
        }
    }
#pragma unroll
    for (int r = 0; r < 16; ++r) { const int i = ib * 32 + crow(r, hi); const float bb = bs[g * 128 + i];
#pragma unroll
        for (int c = 0; c < 2; ++c) st[i * GST + (cb0 + c) * 32 + r32] = acc[c][r] + bb; }
    __syncthreads();
#pragma unroll
    for (int it = 0; it < 4; ++it) {
        const int item = it * 512 + tid, row = item >> 4, c16 = item & 15;
        const DLAS f32x4* sp = (const DLAS f32x4*)(st + row * GST + c16 * 8); const f32x4 m0 = sp[0], m1 = sp[1];
        const u32x4 u = guv[it], q = g1v[it]; u32x4 w;
#pragma unroll
        for (int i = 0; i < 4; ++i) { const float ml = (i < 2) ? m0[2 * i] : m1[2 * i - 4], mh = (i < 2) ? m0[2 * i + 1] : m1[2 * i - 3];
            w[i] = cvtpk(__uint_as_float(u[i] << 16) * ml * __uint_as_float(q[i] << 16), __uint_as_float(u[i] & 0xffff0000u) * mh * __uint_as_float(q[i] & 0xffff0000u)); }
        *(u32x4*)(GM + (size_t)(rowbase + row) * DM + g * 128 + c16 * 8) = w;
    }
    __syncthreads();
}
#undef MX3
#undef MFMA32
#undef WAIT_BAR
#undef BAR_ALL
}

#ifndef REP_P0
#define REP_P0 1
#endif
#ifndef REP_P2A
#define REP_P2A 1
#endif
#ifndef REP_G4
#define REP_G4 1
#endif
#ifndef REP_ATTN
#define REP_ATTN 1
#endif
#ifndef REP_G1
#define REP_G1 1
#endif
#ifndef STOP_AFTER
#define STOP_AFTER 0
#endif
constexpr int NWAVES = 8;
constexpr int M = 16 * 2048, D = 1024, DIN = 7168, DFF = 2816;
constexpr size_t MiB = 1u << 20;
constexpr size_t WS_CTL = 0, CTL_ZERO_BYTES = 1 * MiB;
constexpr size_t WS_WIN = 2 * MiB, WS_WOUT = 16 * MiB, WS_WFFI = 18 * MiB, WS_WFFO = 29 * MiB, WS_WSP = 35 * MiB, WS_ROPE = 36 * MiB;
constexpr size_t WS_SS0 = 38 * MiB, WS_SS1 = 40 * MiB, WS_SS2 = 42 * MiB;
constexpr size_t WS_XN = 48 * MiB, WS_Q = 112 * MiB, WS_K = 176 * MiB, WS_V = 240 * MiB, WS_GU = 304 * MiB, WS_GV = 368 * MiB, WS_END = 432 * MiB;
static_assert(WS_WFFO + (size_t)D * DFF * 2 <= WS_WSP && WS_K + (size_t)M * DFF * 2 <= WS_GV, "d_ws map");
constexpr int CW_BAR = 4096;
constexpr int RING_OFF = 0, RING_BYTES = 131072;
constexpr int LDSCTL_OFF = RING_BYTES, MISC_OFF = LDSCTL_OFF + 320, WSF_OFF = LDSCTL_OFF + 4096;
constexpr int LDS_BYTES = 147456;
#define GAS __attribute__((address_space(1)))
#define LAS __attribute__((address_space(3)))
typedef unsigned short bf16;
typedef unsigned v4u __attribute__((ext_vector_type(4)));
typedef float f32x4 __attribute__((ext_vector_type(4)));
typedef short bf16x8 __attribute__((ext_vector_type(8)));
typedef GAS unsigned gu32;
typedef GAS unsigned long long gu64;
#define RLX_AGENT __ATOMIC_RELAXED, __HIP_MEMORY_SCOPE_AGENT
#define LDS_WAIT() asm volatile("s_waitcnt lgkmcnt(0)" ::: "memory")
#define VM_WAIT() asm volatile("s_waitcnt vmcnt(0)" ::: "memory")
__device__ __forceinline__ unsigned long long rt() { return __builtin_amdgcn_s_memrealtime(); }
__device__ __forceinline__ unsigned f2bf(float f) { unsigned u = __builtin_bit_cast(unsigned, f); return (u + 0x7fffu + ((u >> 16) & 1u)) >> 16; }
__device__ __forceinline__ unsigned pk2(float lo, float hi) { return f2bf(lo) | (f2bf(hi) << 16); }

#define XB_TMO      128
#define XB_XCNT(j)  (256  + 64 * (j))
#define XB_XSUB(j)  (1280 + 64 * (j))
#define XB_XGEN(j)  (2304 + 64 * (j))
#define XB_TOP      3328
#define XB_TOPGEN   3392
#define XCD_BAR_WORDS 3456
#define XB_SPIN_CAP (1u << 18)

__device__ __forceinline__ unsigned xb_ld(unsigned* p)              { return __hip_atomic_load(p, __ATOMIC_RELAXED, __HIP_MEMORY_SCOPE_AGENT); }
__device__ __forceinline__ unsigned xb_add(unsigned* p, unsigned v) { return __hip_atomic_fetch_add(p, v, __ATOMIC_RELAXED, __HIP_MEMORY_SCOPE_AGENT); }
__device__ __forceinline__ unsigned xb_xcc_id() { return (unsigned)__builtin_amdgcn_s_getreg((3 << 11) | 20) & 0xFu; }
#define XB_SPIN(cond, bar) do { unsigned _sp = 0; while (cond) { __builtin_amdgcn_s_sleep(1); \
    if ((++_sp & 255u) == 0u) { if (xb_ld(&(bar)[XB_TMO])) break; if (_sp > XB_SPIN_CAP) { atomicAdd(&(bar)[XB_TMO], 1u); break; } } } } while (0)

struct XcdBarrier {
    unsigned* bar; unsigned x;
    volatile LAS unsigned* st;
};

__device__ __forceinline__ XcdBarrier xcd_barrier_post(unsigned* bar, volatile LAS unsigned* st) {
    XcdBarrier b; b.bar = bar; b.x = xb_xcc_id(); b.st = st;
    if (threadIdx.x == 0) (void)xb_add(&bar[XB_XCNT(b.x)], 1u);
    return b;
}
__device__ __forceinline__ void xcd_barrier_complete(unsigned* bar, unsigned x, unsigned& nloc, unsigned& nx) {
    const unsigned G = gridDim.x * gridDim.y * gridDim.z;
    unsigned sum, cnt, mine, sp = 0u;
    for (;;) {
        sum = 0u; cnt = 0u; mine = 0u;
#pragma unroll
        for (unsigned j = 0; j < 16; ++j) { const unsigned c = xb_ld(&bar[XB_XCNT(j)]); sum += c; cnt += (c > 0u) ? 1u : 0u; mine = (j == x) ? c : mine; }
        if (sum == G) break;
        __builtin_amdgcn_s_sleep(1);
        if ((++sp & 255u) == 0u) { if (xb_ld(&bar[XB_TMO])) break; if (sp > XB_SPIN_CAP) { atomicAdd(&bar[XB_TMO], 1u); break; } }
    }
    nloc = mine > 0u ? mine : 1u; nx = cnt > 0u ? cnt : 1u;
}

__device__ __forceinline__ void xcd_barrier(const XcdBarrier& b) {
    asm volatile("s_waitcnt vmcnt(0)" ::: "memory");
    __syncthreads();
    if (threadIdx.x == 0) {
        unsigned* bar = b.bar;
        __builtin_amdgcn_s_waitcnt(0);
        unsigned nloc = b.st[0], nx = b.st[1];
        if (nloc == 0u) { xcd_barrier_complete(bar, b.x, nloc, nx); b.st[0] = nloc; b.st[1] = nx; }
        const unsigned old = xb_add(&bar[XB_XSUB(b.x)], 1u);
        const unsigned gen = old / nloc;
        if (old + 1u == (gen + 1u) * nloc) {
            __builtin_amdgcn_fence(__ATOMIC_RELEASE, "agent");
            asm volatile("s_waitcnt vmcnt(0)" ::: "memory");
            const unsigned og = xb_add(&bar[XB_TOP], 1u);
            const unsigned tg = og / nx;
            if (og + 1u == (tg + 1u) * nx) xb_add(&bar[XB_TOPGEN], 1u);
            else XB_SPIN(xb_ld(&bar[XB_TOPGEN]) == tg, bar);
            __builtin_amdgcn_fence(__ATOMIC_ACQUIRE, "agent");
            xb_add(&bar[XB_XGEN(b.x)], 1u);
            asm volatile("s_waitcnt vmcnt(0)" ::: "memory");
        } else {
            XB_SPIN(xb_ld(&bar[XB_XGEN(b.x)]) == gen, bar);
            __builtin_amdgcn_fence(__ATOMIC_ACQUIRE, "agent");
            asm volatile("s_waitcnt vmcnt(0)" ::: "memory");
        }
    }
    __syncthreads();
}
struct Frame {
    LAS unsigned char* lds;
    volatile LAS unsigned* MISC;
    gu32* ctl;
    int tid, lane, wave;
    int vcu, G;
};

__device__ __forceinline__ float wave_sum(float v) {
#pragma unroll
    for (int o = 1; o < 64; o <<= 1) v += __shfl_xor(v, o);
    return v;
}
__device__ __forceinline__ void p0_transpose_item(const float* W, int K, int N, bf16* WT, int n0d, int n0s, int k0, const float* kscale, LAS float* scr, int lane) {
    float wv[32];
#pragma unroll
    for (int i = 0; i < 32; ++i) { const int kk = 2 * i + (lane >> 5); wv[i] = W[(size_t)(k0 + kk) * N + n0s + (lane & 31)]; }
    if (kscale) {
#pragma unroll
        for (int i = 0; i < 32; ++i) wv[i] *= kscale[k0 + 2 * i + (lane >> 5)]; }
#pragma unroll
    for (int i = 0; i < 32; ++i) { const int kk = 2 * i + (lane >> 5); scr[kk * 33 + (lane & 31)] = wv[i]; }
    LDS_WAIT(); asm volatile("" ::: "memory");
    const int c = lane & 7;
#pragma unroll
    for (int j = 0; j < 4; ++j) { const int n = (lane >> 3) + 8 * j; const LAS float* s = scr + (8 * c) * 33 + n;
        v4u o; o.x = pk2(s[0 * 33], s[1 * 33]); o.y = pk2(s[2 * 33], s[3 * 33]); o.z = pk2(s[4 * 33], s[5 * 33]); o.w = pk2(s[6 * 33], s[7 * 33]);
        *(GAS v4u*)(WT + (size_t)(n0d + n) * K + k0 + 8 * c) = o; }
    LDS_WAIT(); asm volatile("" ::: "memory");
}

struct Args { const float* in[15]; float* out; unsigned char* ws; };

__global__ void __launch_bounds__(NWAVES * 64, 2) skel_fwd(Args args) {
    extern __shared__ __attribute__((aligned(16))) unsigned char lds[];
    Frame F;
    F.lds = (LAS unsigned char*)lds;
    F.MISC = (volatile LAS unsigned*)(F.lds + MISC_OFF);
    F.tid = threadIdx.x; F.lane = F.tid & 63; F.wave = __builtin_amdgcn_readfirstlane(F.tid >> 6);
    F.G = gridDim.x; { const int bx = blockIdx.x; F.vcu = (F.G % 8 == 0) ? (bx % 8) * (F.G / 8) + bx / 8 : bx; }
    unsigned char* ws = args.ws;
    F.ctl = (gu32*)(ws + WS_CTL);
    const float* x = args.in[0]; const int* positions = (const int*)args.in[1]; const float* norm_mix_g = args.in[2]; const float* w_in = args.in[3];
    const float* gate_b = args.in[4]; const float* lambdas = args.in[5]; const float* subln_g = args.in[6]; const float* gm_norm_g = args.in[7];
    const float* gm_ws = args.in[8]; const float* gm_bs = args.in[9]; const float* w_out = args.in[10]; const float* norm_ffn_g = args.in[11];
    const float* w_ffn_in = args.in[12]; const float* w_ffn_out = args.in[13]; const float* norm_final_g = args.in[14];
    float* out = args.out;
    bf16* Win_t = (bf16*)(ws + WS_WIN); bf16* Wout_t = (bf16*)(ws + WS_WOUT); bf16* Wffi_t = (bf16*)(ws + WS_WFFI); bf16* Wffo_t = (bf16*)(ws + WS_WFFO);
    bf16* Wsp = (bf16*)(ws + WS_WSP); float* rope = (float*)(ws + WS_ROPE);
    float* gvss = (float*)(ws + WS_SS0); float* x1ss = (float*)(ws + WS_SS1); float* x2ss = (float*)(ws + WS_SS2);
    bf16* XN = (bf16*)(ws + WS_XN); bf16* GMB = (bf16*)(ws + WS_XN);
    bf16* QB_ = (bf16*)(ws + WS_Q); bf16* KB = (bf16*)(ws + WS_K); bf16* VB = (bf16*)(ws + WS_V); bf16* GU = (bf16*)(ws + WS_GU); bf16* GV = (bf16*)(ws + WS_GV);
    bf16* MERGED = (bf16*)(ws + WS_GU);
    bf16* G0 = (bf16*)out; bf16* G1 = (bf16*)out + (size_t)M * D;
    bf16* X1B = (bf16*)(ws + WS_Q);
    bf16* ACT = (bf16*)(ws + WS_K);

    for (int u = F.tid; u < (LDS_BYTES - LDSCTL_OFF) / 4; u += NWAVES * 64) ((LAS unsigned*)(F.lds + LDSCTL_OFF))[u] = 0u;
    __syncthreads();
    XcdBarrier bar = xcd_barrier_post((unsigned*)(F.ctl + CW_BAR), F.MISC + 8);
    const int gw = F.vcu * NWAVES + F.wave, NGW = F.G * NWAVES;

    for (int rep0 = 0; rep0 < REP_P0; ++rep0) {
        LAS float* scr = (LAS float*)(F.lds + RING_OFF + F.wave * 16384);
        constexpr int I_IN = (D / 64) * (DIN / 32), I_OUT = (D / 64) * (D / 32), I_FFI = (D / 64) * (2 * DFF / 32), I_FFO = (DFF / 64) * (D / 32);
        constexpr int NITEMS = I_IN + I_OUT + I_FFI + I_FFO;
        for (int it = gw; it < NITEMS; it += NGW) {
            int r = it;
            if (r < I_IN) { const int nblk = DIN / 32, kb = r / nblk, nb = r % nblk; p0_transpose_item(w_in, D, DIN, Win_t, 32 * nb, 32 * nb, 64 * kb, nullptr, scr, F.lane); continue; } r -= I_IN;
            if (r < I_OUT) { const int nblk = D / 32, kb = r / nblk, nb = r % nblk; p0_transpose_item(w_out, D, D, Wout_t, 32 * nb, 32 * nb, 64 * kb, nullptr, scr, F.lane); continue; } r -= I_OUT;
            if (r < I_FFI) { const int nblk = 2 * DFF / 32, kb = r / nblk, nb = r % nblk; const int n0d = 32 * nb, j = n0d >> 8, c = n0d & 255;
                const int n0s = (c < 128) ? 128 * j + c : DFF + 128 * j + (c - 128);
                p0_transpose_item(w_ffn_in, D, 2 * DFF, Wffi_t, n0d, n0s, 64 * kb, norm_ffn_g, scr, F.lane); continue; } r -= I_FFI;
            { const int nblk = D / 32, kb = r / nblk, nb = r % nblk; p0_transpose_item(w_ffn_out, DFF, D, Wffo_t, 32 * nb, 32 * nb, 64 * kb, nullptr, scr, F.lane); }
        }
        for (int e = (int)blockIdx.x * (NWAVES * 64) + F.tid; e < 8 * 128 * 128; e += F.G * NWAVES * 64) {
            const int jp = e & 127, i = (e >> 7) & 127, g = e >> 14; const int ks = jp >> 4, hh = (jp >> 3) & 1, jj = jp & 7; const int j = 16 * ks + 8 * (jj >> 2) + 4 * hh + (jj & 3);
            const float v = ((j >> 6) <= (i >> 6)) ? gm_ws[(size_t)(g * 128 + i) * 128 + j] : 0.f;
            Wsp[e] = (bf16)f2bf(v);
        }
        for (int e = (int)blockIdx.x * (NWAVES * 64) + F.tid; e < M * 8; e += F.G * NWAVES * 64) {
            const int m = e >> 3, i = e & 7;
            const float fr = (i == 0) ? 1.0f : (i == 1) ? 0.1939227432012558f : (i == 2) ? 0.03760603070259094f : (i == 3) ? 0.007292664609849453f : (i == 4) ? 0.0014142135623842478f
                           : (i == 5) ? 0.00027424818836152554f : (i == 6) ? 5.318296098266728e-05f : 1.0313386155758053e-05f;
            const float ang = (float)positions[m] * fr;
            const double tt = (double)ang * 0.15915494309189535; const float tf = (float)(tt - __builtin_rint(tt));
            rope[(size_t)m * 16 + i] = __builtin_amdgcn_cosf(tf); rope[(size_t)m * 16 + 8 + i] = __builtin_amdgcn_sinf(tf);
        }
        { f32x4 gg[4];
#pragma unroll
          for (int j = 0; j < 4; ++j) gg[j] = *((const f32x4*)norm_mix_g + F.lane + 64 * j);
          for (int m0 = gw * 4; m0 < M; m0 += NGW * 4) {
            f32x4 v[4][4];
#pragma unroll
            for (int r = 0; r < 4; ++r) { const GAS f32x4* xr = (const GAS f32x4*)(x + (size_t)(m0 + r) * D) + F.lane;
#pragma unroll
                for (int j = 0; j < 4; ++j) v[r][j] = xr[64 * j]; }
            float s[4];
#pragma unroll
            for (int r = 0; r < 4; ++r) { s[r] = 0.f;
#pragma unroll
                for (int j = 0; j < 4; ++j) s[r] += (v[r][j].x * v[r][j].x + v[r][j].y * v[r][j].y) + (v[r][j].z * v[r][j].z + v[r][j].w * v[r][j].w); }
#pragma unroll
            for (int o = 1; o < 64; o <<= 1) {
#pragma unroll
                for (int r = 0; r < 4; ++r) s[r] += __shfl_xor(s[r], o); }
#pragma unroll
            for (int r = 0; r < 4; ++r) { const float rinv = __builtin_amdgcn_rsqf(s[r] * (1.f / D) + 1e-6f);
                GAS unsigned long long* o8 = (GAS unsigned long long*)(XN + (size_t)(m0 + r) * D) + F.lane;
#pragma unroll
                for (int j = 0; j < 4; ++j) o8[64 * j] = (unsigned long long)pk2(v[r][j].x * rinv * gg[j].x, v[r][j].y * rinv * gg[j].y) | ((unsigned long long)pk2(v[r][j].z * rinv * gg[j].z, v[r][j].w * rinv * gg[j].w) << 32); }
          } }
    }
    xcd_barrier(bar);

#if STOP_AFTER == 10
    { const size_t n = (size_t)M * D; for (size_t i = (size_t)blockIdx.x * 512 + F.tid; i < n; i += (size_t)F.G * 512)
        out[i] = pg8::bf2f(XN[i]) + pg8::bf2f(Win_t[i % ((size_t)DIN * D)]) + pg8::bf2f(Wffi_t[i % ((size_t)2 * DFF * D)]) + pg8::bf2f(Wffo_t[i % ((size_t)DFF * D)]) + pg8::bf2f(Wout_t[i % ((size_t)D * D)]) + rope[i % ((size_t)M * 16)] + pg8::bf2f(Wsp[i % 131072]); }
    return;
#endif
    {
        pg8::Gemm g{XN, Win_t, M, DIN, D}; pg8::StaticOrder S; S.init(M, DIN, F.G, (int)blockIdx.x);
        pg8::EpiProj E; E.dst5 = QB_; E.dstg = G0;
        E.rope = rope; E.gate_b = gate_b; E.gnorm = gm_norm_g; E.gvss = gvss; E.qscale = dattn::C2;
        pg8::gemm_phase<pg8::EpiProj, pg8::StaticOrder, true, true>(F.lds + RING_OFF, g, S, E);
#if REP_G1 == 2
        pg8::gemm_phase<pg8::EpiProj, pg8::StaticOrder, true, true>(F.lds + RING_OFF, g, S, E);
#endif
    }
    xcd_barrier(bar);
#if STOP_AFTER == 1
    { const size_t n = (size_t)M * D; const unsigned* gp = (const unsigned*)out;
      for (size_t i = (size_t)blockIdx.x * 512 + F.tid; i < n; i += (size_t)F.G * 512) { const unsigned g2 = gp[i];
        out[i] = __uint_as_float(g2 << 16) + __uint_as_float(g2 & 0xffff0000u) + pg8::bf2f(QB_[i]) + pg8::bf2f(KB[i]) + pg8::bf2f(VB[i]) + pg8::bf2f(GU[i]) + pg8::bf2f(GV[i]) + gvss[i & ((size_t)M * 16 - 1)] * 0.001f; } }
    return;
#endif

    {
        const int per = (2048 + F.G - 1) / F.G;
        for (int rep = 0; rep < REP_P2A; ++rep)
        for (int i = 0; i < per; ++i) { const int id = F.vcu * per + i; if (id < 2048) dattn::gmlp_unit(id >> 7, (id >> 3) & 15, id & 7, GV, GU, G1, gvss, Wsp, gm_bs, GMB, F.lds + RING_OFF); }
    }
    xcd_barrier(bar);
#if STOP_AFTER == 2
    { const size_t n = (size_t)M * D; for (size_t i = (size_t)blockIdx.x * 512 + F.tid; i < n; i += (size_t)F.G * 512) out[i] = pg8::bf2f(GMB[i]); }
    return;
#endif

    {
        const float a = lambdas[F.lane] * lambdas[64 + F.lane], c = lambdas[128 + F.lane] * lambdas[192 + F.lane];
        const float lam = __expf(wave_sum(a)) - __expf(wave_sum(c)) + 0.2f;
        const int per = (1024 + F.G - 1) / F.G;
        for (int rep = 0; rep < REP_ATTN; ++rep)
        for (int j = 0; j < per; ++j) { const int pr = F.vcu * per + j; if (pr >= 1024) break; const int bh = pr >> 3, s = pr & 7;
            for (int k = 0; k < 2; ++k) dattn::unit(bh >> 3, bh & 7, k ? 15 - s : s, QB_, KB, VB, G0, GMB, MERGED, subln_g, lam, F.lds + RING_OFF, (LAS float*)(F.lds + WSF_OFF)); }
    }
    xcd_barrier(bar);
#if STOP_AFTER == 3
    { const size_t n = (size_t)M * D; for (size_t i = (size_t)blockIdx.x * 512 + F.tid; i < n; i += (size_t)F.G * 512) out[i] = pg8::bf2f(MERGED[i]); }
    return;
#endif

    {
        pg8::Gemm g{MERGED, Wout_t, M, D, D}; pg8::StaticOrder S; S.init(M, D, F.G, (int)blockIdx.x);
        pg8::EpiResid E{x, out, X1B, x1ss};
        pg8::gemm_phase<pg8::EpiResid, pg8::StaticOrder, true, true>(F.lds + RING_OFF, g, S, E);
    }
    xcd_barrier(bar);
#if STOP_AFTER == 4
    return;
#endif

    {
        pg8::Gemm g{X1B, Wffi_t, M, 2 * DFF, D}; pg8::StaticOrder S; S.init(M, 2 * DFF, F.G, (int)blockIdx.x);
        pg8::EpiSwiglu E{ACT, x1ss, DFF};
        pg8::gemm_phase<pg8::EpiSwiglu, pg8::StaticOrder, true, true>(F.lds + RING_OFF, g, S, E);
#if REP_G4 == 2
        pg8::gemm_phase<pg8::EpiSwiglu, pg8::StaticOrder, true, true>(F.lds + RING_OFF, g, S, E);
#endif
    }
    xcd_barrier(bar);
#if STOP_AFTER == 5
    { const size_t n = (size_t)M * D; for (size_t i = (size_t)blockIdx.x * 512 + F.tid; i < n; i += (size_t)F.G * 512) out[i] = pg8::bf2f(ACT[i]) + pg8::bf2f(ACT[i + n]); }
    return;
#endif

    {
        pg8::Gemm g{ACT, Wffo_t, M, D, DFF}; pg8::StaticOrder S; S.init(M, D, F.G, (int)blockIdx.x);
        pg8::EpiResid E{out, out, nullptr, x2ss};
        pg8::gemm_phase<pg8::EpiResid, pg8::StaticOrder, true, true>(F.lds + RING_OFF, g, S, E);
    }
    xcd_barrier(bar);

    {
        const unsigned poison = xb_ld((unsigned*)(F.ctl + CW_BAR) + XB_TMO);
        for (int m = gw; m < M; m += NGW) {
            GAS f32x4* xr = (GAS f32x4*)(out + (size_t)m * D) + F.lane; f32x4 v[4];
#pragma unroll
            for (int j = 0; j < 4; ++j) v[j] = xr[64 * j];
            float s = x2ss[(size_t)m * 16 + (F.lane & 15)];
            s += __shfl_xor(s, 1); s += __shfl_xor(s, 2); s += __shfl_xor(s, 4); s += __shfl_xor(s, 8);
            float rinv = __builtin_amdgcn_rsqf(s * (1.f / D) + 1e-6f);
            if (poison) rinv = __builtin_nanf("");
#pragma unroll
            for (int j = 0; j < 4; ++j) { const f32x4 gg = *((const f32x4*)norm_final_g + F.lane + 64 * j); xr[64 * j] = v[j] * rinv * gg; }
        }
    }
}

extern "C" void kernel_launch(void* const* d_in, const int* in_sizes, int n_in, void* d_out, int out_size, void* d_ws, size_t ws_size, hipStream_t stream) {
    static int grid = 0;
    if (grid == 0) {
        if (n_in != 15 || in_sizes[0] != M * D || out_size != M * D || ws_size < WS_END) { fprintf(stderr, "kernel_launch: unexpected shapes (n_in %d, in0 %d, out %d, ws %zu < %zu); nothing launched\n", n_in, n_in > 0 ? in_sizes[0] : -1, out_size, ws_size, (size_t)WS_END); grid = -1; return; }
        int dev = 0, cus = 0;
        if (hipGetDevice(&dev) != hipSuccess || hipDeviceGetAttribute(&cus, hipDeviceAttributeMultiprocessorCount, dev) != hipSuccess) { fprintf(stderr, "kernel_launch: device query failed\n"); grid = -1; return; }
        if (hipFuncSetAttribute((const void*)skel_fwd, hipFuncAttributeMaxDynamicSharedMemorySize, LDS_BYTES) != hipSuccess) { fprintf(stderr, "kernel_launch: hipFuncSetAttribute failed\n"); grid = -1; return; }
        int per_cu = 0;
        if (hipOccupancyMaxActiveBlocksPerMultiprocessor(&per_cu, (const void*)skel_fwd, NWAVES * 64, LDS_BYTES) != hipSuccess || per_cu < 1) fprintf(stderr, "kernel_launch: note: occupancy query reports %d\n", per_cu);
        (void)hipGetLastError();
        grid = cus;
        if (grid != 256) fprintf(stderr, "kernel_launch: %d CUs; the unit dealing assumes 256\n", grid);
    }
    if (grid < 0) return;
    if (hipMemsetAsync((char*)d_ws + WS_CTL, 0, CTL_ZERO_BYTES, stream) != hipSuccess) { fprintf(stderr, "kernel_launch: hipMemsetAsync failed\n"); return; }
    Args a{};
    for (int i = 0; i < 15; ++i) a.in[i] = (const float*)d_in[i];
    a.out = (float*)d_out; a.ws = (unsigned char*)d_ws;
    hipLaunchKernelGGL(skel_fwd, dim3(grid), dim3(NWAVES * 64), LDS_BYTES, stream, a);
    const hipError_t le = hipPeekAtLastError();
    if (le != hipSuccess) fprintf(stderr, "kernel_launch: launch failed: %s\n", hipGetErrorName(le));
}
```
